# Optimizing an MI355X kernel written in HIP

```python
import math
import jax, jax.numpy as jnp
from jax import lax
import numpy as np

D_MODEL = 4096
BATCH = 2
SEQ = 8192
DEPTH = 1
DEC_BATCH = 32
DEC_SEQ = 64
PAST_LEN = 2048

CHUNK = 64
D_MIX = D_MODEL
GDN_DK = 128
GDN_DV = 128
GDN_HEADS = (D_MIX // 2) // GDN_DV
GDN_QK = GDN_HEADS * GDN_DK
GDN_V = GDN_HEADS * GDN_DV
ML_HEADS = 8
ML_DV = (D_MIX // 2) // ML_HEADS
ML_DQK = ML_DV // 2
ML_QK = ML_HEADS * ML_DQK
ML_V = ML_HEADS * ML_DV
CONV_W = 4
CONV_CH = 2 * GDN_QK + GDN_V
D_IN = 2 * GDN_QK + 2 * GDN_V + 2 * GDN_HEADS + 2 * ML_QK + 3 * ML_V + 2 * ML_HEADS
EPS = 1e-6
FORGET_BIAS = 3.0

kernel_name = 'hymba_gdn_mlstm_stream_step'


def rmsnorm(x, g):
    xf = x.astype(jnp.float32)
    y = xf * lax.rsqrt(jnp.mean(xf * xf, -1, keepdims=True) + EPS) * g.astype(jnp.float32)
    return y.astype(x.dtype)


def head_rms(x):
    return x * lax.rsqrt(jnp.mean(x * x, -1, keepdims=True) + EPS)


def l2norm(x):
    return x * lax.rsqrt(jnp.sum(x * x, -1, keepdims=True) + EPS)


def split_columns(proj):
    sizes = (GDN_QK, GDN_QK, GDN_V, GDN_V, GDN_HEADS, GDN_HEADS,
             ML_QK, ML_QK, ML_V, ML_V, ML_V, ML_HEADS, ML_HEADS)
    idx = np.cumsum(np.array(sizes))[:-1].tolist()
    return jnp.split(proj, idx, axis=-1)


def causal_conv_silu(u, buf, w):
    T = u.shape[1]
    full = jnp.concatenate([buf, u], axis=1)
    y = full[:, 0:T] * w[0]
    for j in range(1, CONV_W):
        y = y + full[:, j:j + T] * w[j]
    return jax.nn.silu(y), full[:, -(CONV_W - 1):]


def to_blocks(a, nb, L):
    B, T, H = a.shape[:3]
    a = a.reshape((B, nb, L, H) + a.shape[3:])
    return jnp.swapaxes(a, 2, 3)


def gated_delta_chunked(q, k, v, g, beta, S0):
    B, T, H, _ = q.shape
    DV = v.shape[-1]
    L = min(CHUNK, T)
    nb = T // L
    q, k, v, g, beta = (to_blocks(a, nb, L) for a in (q, k, v, g, beta))
    G = jnp.cumsum(g, axis=-1)
    strict = jnp.tril(jnp.ones((L, L), bool), -1)
    incl = jnp.tril(jnp.ones((L, L), bool))
    diff = G[..., :, None] - G[..., None, :]
    dec_strict = jnp.exp(jnp.where(strict, diff, -jnp.inf))
    dec_incl = jnp.exp(jnp.where(incl, diff, -jnp.inf))
    A = beta[..., :, None] * jnp.einsum('bnhtd,bnhsd->bnhts', k, k) * dec_strict
    IA = A + jnp.eye(L, dtype=A.dtype)
    eG = jnp.exp(G)
    W = lax.linalg.triangular_solve(IA, (beta * eG)[..., None] * k, left_side=True, lower=True, unit_diagonal=True)
    Ut = lax.linalg.triangular_solve(IA, beta[..., None] * v, left_side=True, lower=True, unit_diagonal=True)
    QK = jnp.einsum('bnhtd,bnhsd->bnhts', q, k) * dec_incl
    Kd = k * jnp.exp(G[..., -1:] - G)[..., None]
    eGL = eG[..., -1]
    xs = tuple(jnp.moveaxis(a, 1, 0) for a in (q, W, Ut, QK, Kd, eG, eGL))

    def step(S, inp):
        qc, Wc, Uc, QKc, Kdc, eGc, eGLc = inp
        U = Uc - jnp.einsum('bhlk,bhkv->bhlv', Wc, S)
        o = eGc[..., None] * jnp.einsum('bhlk,bhkv->bhlv', qc, S) + jnp.einsum('bhts,bhsv->bhtv', QKc, U)
        S = eGLc[..., None, None] * S + jnp.einsum('bhlk,bhlv->bhkv', Kdc, U)
        return S, o

    S, o = lax.scan(step, S0, xs)
    o = jnp.transpose(o, (1, 0, 3, 2, 4)).reshape(B, T, H, DV)
    return o, S


def mlstm_chunked(q, k, v, logi, logf, C0, n0, m0):
    B, T, H, _ = q.shape
    DV = v.shape[-1]
    L = min(CHUNK, T)
    nb = T // L
    q, k, v, logi, logf = (to_blocks(a, nb, L) for a in (q, k, v, logi, logf))
    b = jnp.cumsum(logf, axis=-1)
    incl = jnp.tril(jnp.ones((L, L), bool))
    D = jnp.where(incl, b[..., :, None] - b[..., None, :] + logi[..., None, :], -jnp.inf)
    Dmax = jnp.max(D, axis=-1)
    QK = jnp.einsum('bnhtd,bnhsd->bnhts', q, k)
    to_end = b[..., -1:] - b + logi
    bL = b[..., -1]
    xs = tuple(jnp.moveaxis(a, 1, 0) for a in (q, k, v, b, D, Dmax, QK, to_end, bL))

    def step(carry, inp):
        C, n, m = carry
        qc, kc, vc, bc, Dc, Dmc, QKc, endc, bLc = inp
        inter = bc + m[..., None]
        mt = jnp.maximum(inter, Dmc)
        P = jnp.exp(Dc - mt[..., None]) * QKc
        wq = jnp.exp(inter - mt)
        num = wq[..., None] * jnp.einsum('bhlk,bhkv->bhlv', qc, C) + jnp.einsum('bhts,bhsv->bhtv', P, vc)
        den = wq * jnp.einsum('bhlk,bhk->bhl', qc, n) + jnp.sum(P, axis=-1)
        h = num / jnp.maximum(jnp.abs(den), jnp.exp(-mt))[..., None]
        m_new = mt[..., -1]
        wC = jnp.exp(bLc + m - m_new)
        ws = jnp.exp(endc - m_new[..., None])
        C = wC[..., None, None] * C + jnp.einsum('bhl,bhlk,bhlv->bhkv', ws, kc, vc)
        n = wC[..., None] * n + jnp.einsum('bhl,bhlk->bhk', ws, kc)
        return (C, n, m_new), h

    (C, n, m), h = lax.scan(step, (C0, n0, m0), xs)
    h = jnp.transpose(h, (1, 0, 3, 2, 4)).reshape(B, T, H, DV)
    return h, C, n, m


def mixer_layer(x, state, norm_g, w_in, conv_w, a_log, dt_bias, gdn_norm_w, b_i, b_f, ml_norm_w, w_out):
    f32 = jnp.float32
    conv_buf, S0, C0, n0, m0 = state
    Bsz, T, _ = x.shape
    h = rmsnorm(x, norm_g)
    proj = jnp.einsum('btd,de->bte', h, w_in).astype(f32)
    gq, gk, gv, gz, gb, ga, mq, mk, mv, mo, mz, mi, mf = split_columns(proj)
    qkv, conv_new = causal_conv_silu(jnp.concatenate([gq, gk, gv], -1), conv_buf.astype(f32), conv_w.astype(f32))
    q, k, v = jnp.split(qkv, [GDN_QK, 2 * GDN_QK], axis=-1)
    q = l2norm(q.reshape(Bsz, T, GDN_HEADS, GDN_DK)) * (GDN_DK ** -0.5)
    k = l2norm(k.reshape(Bsz, T, GDN_HEADS, GDN_DK))
    v = v.reshape(Bsz, T, GDN_HEADS, GDN_DV)
    beta = jax.nn.sigmoid(gb)
    g = -jnp.exp(a_log.astype(f32)) * jax.nn.softplus(ga + dt_bias.astype(f32))
    o, S_new = gated_delta_chunked(q, k, v, g, beta, S0.astype(f32))
    gdn_out = (head_rms(o) * gdn_norm_w.astype(f32) * jax.nn.silu(gz.reshape(Bsz, T, GDN_HEADS, GDN_DV))).reshape(Bsz, T, GDN_V)
    mq = mq.reshape(Bsz, T, ML_HEADS, ML_DQK)
    mk = mk.reshape(Bsz, T, ML_HEADS, ML_DQK) * (ML_DQK ** -0.5)
    mv = mv.reshape(Bsz, T, ML_HEADS, ML_DV)
    logi = mi + b_i.astype(f32)
    logf = jax.nn.log_sigmoid(mf + b_f.astype(f32))
    hc, C_new, n_new, m_new = mlstm_chunked(mq, mk, mv, logi, logf, C0.astype(f32), n0.astype(f32), m0.astype(f32))
    ml_out = (head_rms(hc) * ml_norm_w.astype(f32)).reshape(Bsz, T, ML_V) * jax.nn.sigmoid(mo) * jax.nn.silu(mz)
    mixed = jnp.concatenate([gdn_out, ml_out], axis=-1).astype(x.dtype)
    x = x + jnp.einsum('bte,ed->btd', mixed, w_out)
    return x, (conv_new, S_new, C_new, n_new, m_new)


def setup_inputs(seed: int = 0) -> dict:
    key = jax.random.key(seed)
    ks = jax.random.split(key, 18)
    f32 = jnp.float32
    nrm = lambda kk, s: jax.random.normal(kk, s, f32)
    dt = jnp.exp(jax.random.uniform(ks[11], (DEPTH, GDN_HEADS), f32, math.log(1e-3), math.log(1e-1)))
    return {
        'x_prompt': nrm(ks[0], (BATCH, SEQ, D_MODEL)),
        'x_sample': nrm(ks[1], (DEC_BATCH, DEC_SEQ, D_MODEL)),
        'cache_gdn_conv': nrm(ks[2], (DEPTH, DEC_BATCH, CONV_W - 1, CONV_CH)),
        'state_gdn': 0.05 * nrm(ks[3], (DEPTH, DEC_BATCH, GDN_HEADS, GDN_DK, GDN_DV)),
        'state_mlstm_c': 0.05 * nrm(ks[4], (DEPTH, DEC_BATCH, ML_HEADS, ML_DQK, ML_DV)),
        'state_mlstm_n': 0.1 * nrm(ks[5], (DEPTH, DEC_BATCH, ML_HEADS, ML_DQK)),
        'state_mlstm_m': nrm(ks[6], (DEPTH, DEC_BATCH, ML_HEADS)),
        'norm_g': 1.0 + 0.02 * nrm(ks[7], (DEPTH, D_MODEL)),
        'w_in': nrm(ks[8], (DEPTH, D_MODEL, D_IN)) * (D_MODEL ** -0.5),
        'conv_w': nrm(ks[9], (DEPTH, CONV_W, CONV_CH)) * (CONV_W ** -0.5),
        'gdn_a_log': jnp.log(jax.random.uniform(ks[10], (DEPTH, GDN_HEADS), f32, 1.0, 16.0)),
        'gdn_dt_bias': dt + jnp.log(-jnp.expm1(-dt)),
        'gdn_norm_w': 1.0 + 0.02 * nrm(ks[12], (DEPTH, GDN_DV)),
        'mlstm_b_i': 0.01 * nrm(ks[13], (DEPTH, ML_HEADS)),
        'mlstm_b_f': FORGET_BIAS + 0.1 * nrm(ks[14], (DEPTH, ML_HEADS)),
        'mlstm_norm_w': 1.0 + 0.02 * nrm(ks[15], (DEPTH, ML_DV)),
        'w_out': nrm(ks[16], (DEPTH, D_MIX, D_MODEL)) * (D_MIX ** -0.5),
        'final_g': 1.0 + 0.02 * nrm(ks[17], (D_MODEL,)),
    }


def reference(x_prompt, x_sample, cache_gdn_conv, state_gdn, state_mlstm_c, state_mlstm_n, state_mlstm_m,
              norm_g, w_in, conv_w, gdn_a_log, gdn_dt_bias, gdn_norm_w, mlstm_b_i, mlstm_b_f, mlstm_norm_w,
              w_out, final_g):
    f32 = jnp.float32
    B = x_prompt.shape[0]
    xp, xs = x_prompt, x_sample
    p_st, s_st = [], []
    for l in range(DEPTH):
        lw = (norm_g[l], w_in[l], conv_w[l], gdn_a_log[l], gdn_dt_bias[l], gdn_norm_w[l],
              mlstm_b_i[l], mlstm_b_f[l], mlstm_norm_w[l], w_out[l])
        fresh = (jnp.zeros((B, CONV_W - 1, CONV_CH), f32),
                 jnp.zeros((B, GDN_HEADS, GDN_DK, GDN_DV), f32),
                 jnp.zeros((B, ML_HEADS, ML_DQK, ML_DV), f32),
                 jnp.zeros((B, ML_HEADS, ML_DQK), f32),
                 jnp.zeros((B, ML_HEADS), f32))
        carried = (cache_gdn_conv[l], state_gdn[l], state_mlstm_c[l], state_mlstm_n[l], state_mlstm_m[l])
        xp, sp = mixer_layer(xp, fresh, *lw)
        xs, ss = mixer_layer(xs, carried, *lw)
        p_st.append(sp)
        s_st.append(ss)
    y_prompt = rmsnorm(xp, final_g)
    y_sample = rmsnorm(xs, final_g)
    stk = lambda sts, i: jnp.stack([s[i] for s in sts])
    return (y_prompt, y_sample,
            stk(p_st, 0), stk(p_st, 1), stk(p_st, 2), stk(p_st, 3), stk(p_st, 4),
            stk(s_st, 0), stk(s_st, 1), stk(s_st, 2), stk(s_st, 3), stk(s_st, 4))
```

```cpp
#include <hip/hip_runtime.h>
#include <hip/hip_cooperative_groups.h>
#include <cstdio>
namespace cg = cooperative_groups;
#define N_LAUNCH_SPLIT 7
namespace pg8 {
#define PG8_LAS __attribute__((address_space(3)))
typedef unsigned short bf16_t;
typedef short bf16x8 __attribute__((ext_vector_type(8)));
typedef float f32x4 __attribute__((ext_vector_type(4)));
typedef unsigned u32x4 __attribute__((ext_vector_type(4)));
constexpr int BM = 256, BK = 64, HALF = 128, HTB = HALF * BK * 2  , STAGE_BYTES = 8 * HTB, NXCD = 8, WGM = 8;

__host__ __device__ __forceinline__ int lds_byte(int r, int c) { const int st = (r >> 4) * 2 + (c >> 5), rr = r & 15, cc = c & 31, ob = rr * 64 + cc * 2; return st * 1024 + (ob ^ (((ob >> 9) & 1) << 5)); }
__host__ __device__ __forceinline__ void stage_rc(int b, int& R, int& C) { const int st = b / 1024, sb = b % 1024, swz = sb ^ (((sb >> 9) & 1) << 5); R = (st >> 1) * 16 + swz / 64; C = (st & 1) * 32 + (swz % 64) / 2; }
__host__ __device__ __forceinline__ int perm32(int rho) { const int n = rho >> 4, i = rho & 15; return 8 * (i >> 2) + 4 * n + (i & 3); }

struct Unit { int pm, pn; };
struct Gemm { const bf16_t* A; const bf16_t* Bt; int M, N, K; };

struct StaticOrder {
    int nM, nN, nwg, G, c;
    __host__ __device__ void init(int M, int N, int G_, int c_) { nM = M / BM; nN = N / BM; nwg = nM * nN; G = G_; c = c_; }
    __host__ __device__ bool next(int i, Unit& u) const {
        const long L = (long)i * G + c; if (L >= nwg) return false;
        int wgid = (int)L; { const int q = nwg / NXCD, r = nwg % NXCD, xcd = wgid % NXCD, off = wgid / NXCD; wgid = (xcd < r ? xcd * (q + 1) : r * (q + 1) + (xcd - r) * q) + off; }
        const int nig = WGM * nN, gid = wgid / nig, fm = gid * WGM, gsz = (nM - fm) < WGM ? (nM - fm) : WGM;
        u.pm = fm + ((wgid % nig) % gsz); u.pn = (wgid % nig) / gsz; return true;
    }
    __device__ __forceinline__ void a_ready(const Unit&) const {}
    __device__ __forceinline__ void done(const Unit&) const {}
};
template <class Epi, class Sched, bool STAMP = false>
__device__ __forceinline__ void gemm_phase(PG8_LAS unsigned char* lds, const Gemm g, const Sched& S, const Epi& E, unsigned long long* stamps) {
    const int tid = threadIdx.x, wid = __builtin_amdgcn_readfirstlane(tid >> 6), lane = tid & 63, wr = wid >> 2, wc = wid & 3, fr = lane & 15, fq = lane >> 4;
    const int K = g.K, nt = K / BK;
    int ts_lo = 0, ts_hi = 0, nts = 0; const unsigned long long rt_entry = STAMP ? (unsigned long long)wall_clock64() : 0ull;
#define PG8_STAMP() do { if (STAMP && wid == 0 && nts < 64) { const unsigned long long _c = (unsigned long long)clock64(); \
        ts_lo = (lane == nts) ? (int)(unsigned)_c : ts_lo; ts_hi = (lane == nts) ? (int)(unsigned)(_c >> 32) : ts_hi; ++nts; } } while (0)
    PG8_STAMP();
    unsigned voffA[2], voffB[2];
#pragma unroll
    for (int i = 0; i < 2; ++i) { int R, C; stage_rc(tid * 16 + i * 8192, R, C); const int Rb = Epi::PERM ? ((R & ~31) + perm32(R & 31)) : R;
        voffA[i] = (unsigned)(R * K + C) * 2u; voffB[i] = (unsigned)(Rb * K + C) * 2u; }
    const size_t kstep = (size_t)(BK * 2);
    const size_t hstep = (size_t)HALF * K * 2;
    const size_t tstep = 2 * hstep;
    const unsigned ldsw = (unsigned)wid * 1024u;
    const int aoff = lds_byte(wr * 64 + fr, fq * 8), boff = lds_byte(wc * 32 + fr, fq * 8);
#define PG8_SA(b, h) (((b) * 2 + (h)) * HTB)
#define PG8_SB(b, h) ((4 + (b) * 2 + (h)) * HTB)
#define PG8_STAGE(bufoff, gbase, voff) do { _Pragma("unroll") for (int _i = 0; _i < 2; ++_i) \
        __builtin_amdgcn_global_load_lds((const unsigned*)((const char*)(gbase) + (voff)[_i]), (PG8_LAS unsigned*)(lds + (bufoff) + ldsw + _i * 8192), 16, 0, 0); } while (0)
#define PG8_LDA(dst, b, h) do { _Pragma("unroll") for (int m = 0; m < 4; ++m) _Pragma("unroll") for (int k = 0; k < 2; ++k) dst[m][k] = *(const PG8_LAS bf16x8*)(lds + PG8_SA(b, h) + aoff + m * 2048 + k * 1024); } while (0)
#define PG8_LDB(dst, b, h) do { _Pragma("unroll") for (int n = 0; n < 2; ++n) _Pragma("unroll") for (int k = 0; k < 2; ++k) dst[n][k] = *(const PG8_LAS bf16x8*)(lds + PG8_SB(b, h) + boff + n * 2048 + k * 1024); } while (0)
#define PG8_MMA(ai, bj, At, Bt) do { __builtin_amdgcn_s_setprio(1); _Pragma("unroll") for (int m = 0; m < 4; ++m) _Pragma("unroll") for (int n = 0; n < 2; ++n) _Pragma("unroll") for (int k = 0; k < 2; ++k) \
        acc[ai][bj][m][n] = __builtin_amdgcn_mfma_f32_16x16x32_bf16(Bt[n][k], At[m][k], acc[ai][bj][m][n], 0, 0, 0); __builtin_amdgcn_s_setprio(0); } while (0)
#define PG8_WAIT_V(n) asm volatile("s_waitcnt vmcnt(" #n ")" ::: "memory")
#define PG8_WAIT_L(n) asm volatile("s_waitcnt lgkmcnt(" #n ")" ::: "memory")
#define PG8_BAR __builtin_amdgcn_s_barrier()
#define PG8_SCHED __builtin_amdgcn_sched_barrier(0)
    Unit cur, nxt; int ui = 0;
    if (!S.next(0, cur)) return;
    f32x4 acc[2][2][4][2];
#pragma unroll
    for (int a = 0; a < 2; ++a)
#pragma unroll
        for (int b = 0; b < 2; ++b)
#pragma unroll
            for (int m = 0; m < 4; ++m)
#pragma unroll
                for (int n = 0; n < 2; ++n) acc[a][b][m][n] = (f32x4){0.f, 0.f, 0.f, 0.f};
    bf16x8 At[4][2], B0[2][2], B1[2][2];
    const char* cA = (const char*)g.A + (size_t)cur.pm * tstep; const char* cB = (const char*)g.Bt + (size_t)cur.pn * tstep;
    S.a_ready(cur);
    PG8_STAGE(PG8_SB(0, 0), cB, voffB); PG8_STAGE(PG8_SA(0, 0), cA, voffA); PG8_STAGE(PG8_SB(0, 1), cB + hstep, voffB); PG8_STAGE(PG8_SA(0, 1), cA + hstep, voffA);
    if (wr == 1) PG8_BAR;
    PG8_WAIT_V(4); PG8_BAR;
    PG8_STAGE(PG8_SB(1, 0), cB + kstep, voffB); PG8_STAGE(PG8_SA(1, 0), cA + kstep, voffA); PG8_STAGE(PG8_SB(1, 1), cB + hstep + kstep, voffB);
    PG8_WAIT_V(6); PG8_BAR;
    PG8_STAMP();
    for (;;) {
        const bool has_next = S.next(ui + 1, nxt);
        const char* nA = has_next ? (const char*)g.A + (size_t)nxt.pm * tstep : cA; const char* nB = has_next ? (const char*)g.Bt + (size_t)nxt.pn * tstep : cB;
        for (int t = 0; t < nt; t += 2) {
            const bool last = (t == nt - 2);
            const char* a1 = cA + (size_t)(t + 1) * kstep;
            const char* a2 = last ? nA : cA + (size_t)(t + 2) * kstep; const char* b2 = last ? nB : cB + (size_t)(t + 2) * kstep;
            const char* a3 = a2 + kstep; const char* b3 = b2 + kstep;
            if (last && has_next) S.a_ready(nxt);
            PG8_LDB(B0, 0, 0); PG8_SCHED; PG8_LDA(At, 0, 0); PG8_STAGE(PG8_SA(1, 1), a1 + hstep, voffA);
            PG8_WAIT_L(8); PG8_BAR; PG8_WAIT_L(0); PG8_MMA(0, 0, At, B0); PG8_BAR; PG8_SCHED;
            PG8_LDB(B1, 0, 1); PG8_STAGE(PG8_SB(0, 0), b2, voffB);
            PG8_BAR; PG8_WAIT_L(0); PG8_MMA(0, 1, At, B1); PG8_BAR;
            PG8_LDA(At, 0, 1); PG8_STAGE(PG8_SA(0, 0), a2, voffA);
            PG8_BAR; PG8_WAIT_L(0); PG8_MMA(1, 0, At, B0); PG8_BAR; PG8_SCHED;
            PG8_STAGE(PG8_SB(0, 1), b2 + hstep, voffB);
            PG8_WAIT_V(6); PG8_BAR; PG8_MMA(1, 1, At, B1); PG8_BAR;
            PG8_LDB(B0, 1, 0); PG8_SCHED; PG8_LDA(At, 1, 0); PG8_STAGE(PG8_SA(0, 1), a2 + hstep, voffA);
            PG8_WAIT_L(8); PG8_BAR; PG8_WAIT_L(0); PG8_MMA(0, 0, At, B0); PG8_BAR; PG8_SCHED;
            PG8_LDB(B1, 1, 1); PG8_STAGE(PG8_SB(1, 0), b3, voffB);
            PG8_BAR; PG8_WAIT_L(0); PG8_MMA(0, 1, At, B1); PG8_BAR;
            PG8_LDA(At, 1, 1); PG8_STAGE(PG8_SA(1, 0), a3, voffA);
            PG8_BAR; PG8_WAIT_L(0); PG8_MMA(1, 0, At, B0); PG8_BAR; PG8_SCHED;
            PG8_STAGE(PG8_SB(1, 1), b3 + hstep, voffB);
            PG8_WAIT_V(6); PG8_BAR; PG8_MMA(1, 1, At, B1); PG8_BAR;
        }
        PG8_STAMP();
        if constexpr (!Epi::AFTER_DRAIN) { E(acc, cur, wr, wc, fr, fq); S.done(cur); }
        PG8_STAMP();
        if (!has_next) break;
#pragma unroll
        for (int a = 0; a < 2; ++a)
#pragma unroll
            for (int b = 0; b < 2; ++b)
#pragma unroll
                for (int m = 0; m < 4; ++m)
#pragma unroll
                    for (int n = 0; n < 2; ++n) acc[a][b][m][n] = (f32x4){0.f, 0.f, 0.f, 0.f};
        cur = nxt; cA = nA; cB = nB; ++ui;
    }
    PG8_WAIT_V(0);
    if (wr == 0) PG8_BAR;
    PG8_BAR;
    if constexpr (Epi::AFTER_DRAIN) { E.fused(acc, cur, wr, wc, fr, fq, lds, wid, lane); S.done(cur); }
    PG8_STAMP();
    if (STAMP && wid == 0) { stamps[lane] = lane < nts ? (((unsigned long long)(unsigned)ts_hi << 32) | (unsigned)ts_lo) : 0ull;
        if (lane == 62) stamps[62] = rt_entry; if (lane == 63) stamps[63] = (unsigned long long)wall_clock64(); }
#undef PG8_STAMP
#undef PG8_SA
#undef PG8_SB
#undef PG8_STAGE
#undef PG8_LDA
#undef PG8_LDB
#undef PG8_MMA
#undef PG8_WAIT_V
#undef PG8_WAIT_L
#undef PG8_BAR
#undef PG8_SCHED
}
}
using pg8::bf16_t; using pg8::bf16x8; using pg8::f32x4; using pg8::u32x4;
typedef float f32x16 __attribute__((ext_vector_type(16)));
typedef __bf16 bf16x2_t __attribute__((ext_vector_type(2)));
typedef float f32x2_t __attribute__((ext_vector_type(2)));
#define DI __device__ __forceinline__
#define LAS __attribute__((address_space(3)))
#define MFMA32(a, b, c) __builtin_amdgcn_mfma_f32_32x32x16_bf16((a), (b), (c), 0, 0, 0)

constexpr int DM = 4096, NTOK = 18432, NPR = 16384, NA = 10240, NB = 6144, N1 = 16640;
constexpr size_t BLOB = 73728;
constexpr size_t OFF_H = 0, OFF_BT1 = 150994944ull, OFF_PREPG = 0, OFF_MIXED = 0, OFF_BT2 = 339738624ull, OFF_PA = OFF_BT2 + 33554432ull,
    OFF_PB = OFF_PA + (size_t)NTOK * NA * 2, OFF_GATES = OFF_PB + (size_t)NTOK * NB * 2, OFF_ORAW = OFF_GATES + (size_t)NTOK * 64 * 4,
    OFF_ROWSS = OFF_ORAW + (size_t)NTOK * 2048 * 2, OFF_EGL = OFF_ROWSS + 73728, OFF_MB = OFF_EGL + 18432, OFF_MDMAX = OFF_MB + 589824,
    OFF_MRS = OFF_MDMAX + 589824, OFF_KN = OFF_MRS + 589824, OFF_NCS = OFF_KN + 1179648, OFF_MCS = OFF_NCS + 1179648, WS_END = OFF_MCS + 9216;
constexpr size_t DO_PREPM = 0, DO_NUM = 2304ull * BLOB;
constexpr size_t O_Y = 0, O_CONV_P = 75497472ull, O_GDN_P = O_CONV_P + 36864, O_C_P = O_GDN_P + 524288, O_N_P = O_C_P + 524288, O_M_P = O_N_P + 2048,
    O_CONV_S = O_M_P + 16, O_GDN_S = O_CONV_S + 589824, O_C_S = O_GDN_S + 8388608, O_N_S = O_C_S + 8388608, O_M_S = O_N_S + 32768;
constexpr int LDS_BYTES = 155648;

struct Params {
    const float *xp, *xs, *cache, *sg, *sc, *sn, *sm, *norm_g, *w_in, *conv_w, *a_log, *dt_bias, *gdn_nw, *b_i, *b_f, *ml_nw, *w_out, *final_g;
    float* out; unsigned char* ws; int ph_lo, ph_hi;
};

DI float bf2f(bf16_t b) { return __uint_as_float(((unsigned)b) << 16); }
DI unsigned pk2(float a, float b) { f32x2_t v = {a, b}; bf16x2_t r = __builtin_convertvector(v, bf16x2_t); return __builtin_bit_cast(unsigned, r); }
DI bf16_t f2bf(float a) { return (bf16_t)(pk2(a, 0.f) & 0xffffu); }
DI bf16x8 pack8(float a0, float a1, float a2, float a3, float a4, float a5, float a6, float a7) {
    u32x4 p; p[0] = pk2(a0, a1); p[1] = pk2(a2, a3); p[2] = pk2(a4, a5); p[3] = pk2(a6, a7); return __builtin_bit_cast(bf16x8, p); }
DI bf16x8 pack_step(const f32x16& x, int s) { return pack8(x[8 * s], x[8 * s + 1], x[8 * s + 2], x[8 * s + 3], x[8 * s + 4], x[8 * s + 5], x[8 * s + 6], x[8 * s + 7]); }
DI int crow(int reg, int h) { return (reg & 3) + 8 * (reg >> 2) + 4 * h; }
DI float wave_sum(float v) { for (int o = 32; o >= 1; o >>= 1) v += __shfl_xor(v, o); return v; }
DI bf16x8 ld8f(const float* p) { const f32x4 a = *(const f32x4*)p, b = *(const f32x4*)(p + 4); return pack8(a[0], a[1], a[2], a[3], b[0], b[1], b[2], b[3]); }
DI float silu_f(float y) { return y / (1.f + __expf(-y)); }
DI float sigm_f(float y) { return 1.f / (1.f + __expf(-y)); }
DI float softplus_f(float x) { return fmaxf(x, 0.f) + log1pf(expf(-fabsf(x))); }

DI int emap1(int n) {
    if (n < 6144) return n;
    if (n < 10240) return 8224 + (n - 6144);
    if (n < 12288) return 6144 + (n - 10240);
    if (n < 16384) return 12320 + (n - 12288);
    if (n < 16416) return 8192 + (n - 16384);
    if (n < 16432) return n;
    return -1;
}
DI void phase0(const Params& p, unsigned char* smem) {
    const int tid = threadIdx.x, lane = tid & 63, wid = tid >> 6;
    const int gw = blockIdx.x * 8 + wid, nw = gridDim.x * 8;
    bf16_t* hb = (bf16_t*)(p.ws + OFF_H);
    for (int row = gw; row < NTOK; row += nw) {
        const float* xr = row < NPR ? p.xp + (size_t)row * DM : p.xs + (size_t)(row - NPR) * DM;
        f32x4 v[16]; float ss = 0.f;
#pragma unroll
        for (int i = 0; i < 16; ++i) { v[i] = *(const f32x4*)(xr + (lane + 64 * i) * 4); ss += v[i][0] * v[i][0] + v[i][1] * v[i][1] + v[i][2] * v[i][2] + v[i][3] * v[i][3]; }
        ss = wave_sum(ss);
        const float rs = rsqrtf(ss * (1.f / DM) + 1e-6f);
#pragma unroll
        for (int i = 0; i < 16; ++i) { const f32x4 g = *(const f32x4*)(p.norm_g + (lane + 64 * i) * 4);
            uint2 o; o.x = pk2(v[i][0] * rs * g[0], v[i][1] * rs * g[1]); o.y = pk2(v[i][2] * rs * g[2], v[i][3] * rs * g[3]);
            *(uint2*)(hb + (size_t)row * DM + (lane + 64 * i) * 4) = o; }
    }
    float* rowss = (float*)(p.ws + OFF_ROWSS);
    for (int i = blockIdx.x * 512 + tid; i < NTOK; i += gridDim.x * 512) rowss[i] = 0.f;
    float* tl = (float*)smem;
    bf16_t* bt1 = (bf16_t*)(p.ws + OFF_BT1); bf16_t* bt2 = (bf16_t*)(p.ws + OFF_BT2);
    const int NT1 = (N1 / 64) * 64, NT2 = 64 * 64;
    for (int tile = blockIdx.x; tile < NT1 + NT2; tile += gridDim.x) {
        const bool second = tile >= NT1; const int tt = second ? tile - NT1 : tile;
        const int n0 = (tt >> 6) * 64, d0 = (tt & 63) * 64;
        const int nn = tid & 63; const int e = second ? (n0 + nn) : emap1(n0 + nn);
        const float* src = second ? p.w_out : p.w_in; const int ld = second ? 4096 : 16432;
#pragma unroll
        for (int i = 0; i < 8; ++i) { const int dd = (tid >> 6) + 8 * i; tl[dd * 65 + nn] = e >= 0 ? src[(size_t)(d0 + dd) * ld + e] : 0.f; }
        __syncthreads();
        const int nn2 = tid >> 3, ds = (tid & 7) * 8;
        const bf16x8 o = pack8(tl[(ds + 0) * 65 + nn2], tl[(ds + 1) * 65 + nn2], tl[(ds + 2) * 65 + nn2], tl[(ds + 3) * 65 + nn2], tl[(ds + 4) * 65 + nn2], tl[(ds + 5) * 65 + nn2], tl[(ds + 6) * 65 + nn2], tl[(ds + 7) * 65 + nn2]);
        *(bf16x8*)((second ? bt2 : bt1) + (size_t)(n0 + nn2) * DM + d0 + ds) = o;
        __syncthreads();
    }
}

struct Epi1 {
    static constexpr bool PERM = true, AFTER_DRAIN = false;
    bf16_t* pa; bf16_t* pb; float* gates;
    DI void operator()(const f32x4 (&acc)[2][2][4][2], const pg8::Unit& u, int wr, int wc, int fr, int fq) const {
        const int row0 = u.pm * 256 + wr * 64 + fr;
        if (u.pn < 64) {
            bf16_t* base; int ldc, colt;
            if (u.pn < 40) { base = pa; ldc = NA; colt = u.pn * 256; } else { base = pb; ldc = NB; colt = (u.pn - 40) * 256; }
            const int col0 = colt + wc * 32 + 8 * fq;
#pragma unroll
            for (int ai = 0; ai < 2; ++ai)
#pragma unroll
                for (int m = 0; m < 4; ++m) { bf16_t* rowp = base + (size_t)(row0 + ai * 128 + m * 16) * ldc + col0;
#pragma unroll
                    for (int bj = 0; bj < 2; ++bj) { const f32x4 v0 = acc[ai][bj][m][0], v1 = acc[ai][bj][m][1];
                        u32x4 w; w[0] = pk2(v0[0], v0[1]); w[1] = pk2(v0[2], v0[3]); w[2] = pk2(v1[0], v1[1]); w[3] = pk2(v1[2], v1[3]);
                        *(u32x4*)(rowp + bj * 128) = w; } }
        } else if (wc < 2) {
#pragma unroll
            for (int ai = 0; ai < 2; ++ai)
#pragma unroll
                for (int m = 0; m < 4; ++m) { float* rowp = gates + (size_t)(row0 + ai * 128 + m * 16) * 64 + wc * 32 + 8 * fq;
                    *(f32x4*)rowp = acc[ai][0][m][0]; *(f32x4*)(rowp + 4) = acc[ai][0][m][1]; }
        }
    }
};
struct Epi2 {
    static constexpr bool PERM = false, AFTER_DRAIN = false;
    const float* xp; const float* xs; float* y; float* rowss;
    DI void operator()(const f32x4 (&acc)[2][2][4][2], const pg8::Unit& u, int wr, int wc, int fr, int fq) const {
        const int row0 = u.pm * 256 + wr * 64 + fr, col0 = u.pn * 256 + wc * 32 + 4 * fq;
#pragma unroll
        for (int ai = 0; ai < 2; ++ai)
#pragma unroll
            for (int m = 0; m < 4; ++m) { const int row = row0 + ai * 128 + m * 16;
                const float* xr = (row < NPR ? xp + (size_t)row * DM : xs + (size_t)(row - NPR) * DM) + col0; float* yr = y + (size_t)row * DM + col0; float ssq = 0.f;
#pragma unroll
                for (int bj = 0; bj < 2; ++bj)
#pragma unroll
                    for (int n = 0; n < 2; ++n) { const f32x4 v = acc[ai][bj][m][n] + *(const f32x4*)(xr + bj * 128 + n * 16); *(f32x4*)(yr + bj * 128 + n * 16) = v;
                        ssq += v[0] * v[0] + v[1] * v[1] + v[2] * v[2] + v[3] * v[3]; }
                ssq += __shfl_xor(ssq, 16); ssq += __shfl_xor(ssq, 32);
                if (fq == 0) atomicAdd(rowss + row, ssq); }
    }
};

template <class F> DI void emit_frags(unsigned char* dst, int MT, int KS, F elem) {
    for (int idx = threadIdx.x; idx < MT * KS * 64; idx += 512) {
        const int f = idx >> 6, l = idx & 63, mt = f / KS, ks = f - mt * KS, r = l & 31, h = l >> 5;
        const int row = mt * 32 + r, cb = (ks >> 1) * 32 + (ks & 1) * 16 + 4 * h;
        const bf16x8 o = pack8(elem(row, cb), elem(row, cb + 1), elem(row, cb + 2), elem(row, cb + 3), elem(row, cb + 8), elem(row, cb + 9), elem(row, cb + 10), elem(row, cb + 11));
        *(bf16x8*)(dst + (size_t)idx * 16) = o;
    }
}

DI void prep_gdn(const Params& p, unsigned char* smem, int cgi, int hd) {
    const int tid = threadIdx.x, lane = tid & 63, wid = tid >> 6, r = lane & 31, h = lane >> 5;
    float* qf = (float*)smem; float* kf = qf + 64 * 132; float* vf = kf + 64 * 132; float* am = vf + 64 * 132; float* qk = am + 64 * 68; float* tm = qk + 64 * 68; float* sc = tm + 64 * 68;
    float* Gs = sc; float* betas = sc + 64; float* eGs = sc + 128; float* decs = sc + 192;
    const int row0 = cgi * 64; const bool sample = cgi >= 256; const bool first = sample || ((cgi & 127) == 0);
    const bf16_t* pa = (const bf16_t*)(p.ws + OFF_PA); const float* gates = (const float*)(p.ws + OFF_GATES);
    unsigned char* blob = p.ws + OFF_PREPG + ((size_t)cgi * 16 + hd) * BLOB;
    for (int idx = tid; idx < 64 * 128; idx += 512) {
        const int t = idx >> 7, ch = idx & 127;
#pragma unroll
        for (int which = 0; which < 3; ++which) {
            const int cc = which * 2048 + hd * 128 + ch; float acc = 0.f;
#pragma unroll
            for (int j = 0; j < 4; ++j) { const int tt = t + j - 3; float xv;
                if (tt >= 0 || !first) xv = bf2f(pa[(size_t)(row0 + tt) * NA + cc]);
                else if (sample) xv = p.cache[((size_t)(cgi - 256) * 3 + (3 + tt)) * 6144 + cc];
                else xv = 0.f;
                acc += xv * p.conv_w[j * 6144 + cc]; }
            (which == 0 ? qf : which == 1 ? kf : vf)[t * 132 + ch] = silu_f(acc);
        }
    }
    for (int idx = tid; idx < 64 * 68; idx += 512) tm[idx] = 0.f;
    if (tid < 64) {
        const float gbv = gates[(size_t)(row0 + tid) * 64 + hd], gav = gates[(size_t)(row0 + tid) * 64 + 16 + hd];
        const float beta = 1.f / (1.f + expf(-gbv));
        const float g = -expf(p.a_log[hd]) * softplus_f(gav + p.dt_bias[hd]);
        float G = g;
#pragma unroll
        for (int o = 1; o < 64; o <<= 1) { const float t2 = __shfl_up(G, o); if (lane >= o) G += t2; }
        const float GL = __shfl(G, 63);
        Gs[tid] = G; betas[tid] = beta; eGs[tid] = expf(G); decs[tid] = expf(GL - G);
        if (tid == 63) ((float*)(p.ws + OFF_EGL))[cgi * 16 + hd] = expf(G);
    }
    __syncthreads();
    for (int rr = 0; rr < 8; ++rr) { const int t = wid * 8 + rr;
        { const float a0 = qf[t * 132 + lane], a1 = qf[t * 132 + 64 + lane]; const float s = rsqrtf(wave_sum(a0 * a0 + a1 * a1) + 1e-6f) * 0.08838834764831845f; qf[t * 132 + lane] = a0 * s; qf[t * 132 + 64 + lane] = a1 * s; }
        { const float a0 = kf[t * 132 + lane], a1 = kf[t * 132 + 64 + lane]; const float s = rsqrtf(wave_sum(a0 * a0 + a1 * a1) + 1e-6f); kf[t * 132 + lane] = a0 * s; kf[t * 132 + 64 + lane] = a1 * s; }
    }
    __syncthreads();
    emit_frags(blob + 16384, 2, 8, [&](int row, int col) { return eGs[row] * qf[row * 132 + col]; });
    emit_frags(blob + 40960, 4, 4, [&](int row, int col) { return kf[col * 132 + row] * decs[col]; });
    { const int mat = wid >> 2, ti = (wid >> 1) & 1, tj = wid & 1; float* dstm = mat ? qk : am;
      if (ti == 0 && tj == 1) {
#pragma unroll
          for (int i = 0; i < 16; ++i) dstm[crow(i, h) * 68 + 32 + r] = 0.f;
      } else {
          const float* A = mat ? qf : kf; f32x16 acc;
#pragma unroll
          for (int i = 0; i < 16; ++i) acc[i] = 0.f;
#pragma unroll
          for (int ks = 0; ks < 8; ++ks) acc = MFMA32(ld8f(A + (ti * 32 + r) * 132 + ks * 16 + h * 8), ld8f(kf + (tj * 32 + r) * 132 + ks * 16 + h * 8), acc);
#pragma unroll
          for (int i = 0; i < 16; ++i) { const int t = ti * 32 + crow(i, h), s = tj * 32 + r;
              const bool keep = mat ? (s <= t) : (s < t); const float d = keep ? __expf(Gs[t] - Gs[s]) : 0.f;
              dstm[t * 68 + s] = mat ? acc[i] * d : betas[t] * acc[i] * d; }
      } }
    __syncthreads();
    emit_frags(blob + 32768, 2, 4, [&](int row, int col) { return qk[row * 68 + col]; });
    if (tid < 64) {
        const int b0 = (tid >> 4) * 16, col = tid & 15;
#pragma unroll 1
        for (int i = 0; i < 16; ++i) { float a = (i == col) ? 1.f : 0.f;
#pragma unroll
            for (int s = 0; s < 16; ++s) { const float cf = (s < i) ? am[(b0 + i) * 68 + b0 + s] : 0.f; a -= cf * tm[(b0 + s) * 68 + b0 + col]; }
            tm[(b0 + i) * 68 + b0 + col] = a; }
    }
    __syncthreads();
    float* tmp = qk;
    { const int B = tid >> 8, i = (tid >> 4) & 15, j = tid & 15, b0 = 32 * B; float a = 0.f;
#pragma unroll
      for (int k = 0; k < 16; ++k) a += am[(b0 + 16 + i) * 68 + b0 + k] * tm[(b0 + k) * 68 + b0 + j];
      tmp[B * 256 + i * 16 + j] = a; }
    __syncthreads();
    { const int B = tid >> 8, i = (tid >> 4) & 15, j = tid & 15, b0 = 32 * B; float a = 0.f;
#pragma unroll
      for (int k = 0; k < 16; ++k) a += tm[(b0 + 16 + i) * 68 + b0 + 16 + k] * tmp[B * 256 + k * 16 + j];
      tm[(b0 + 16 + i) * 68 + b0 + j] = -a; }
    __syncthreads();
    float m1[2];
#pragma unroll
    for (int e = 0; e < 2; ++e) { const int o = tid + 512 * e, i = o >> 5, j = o & 31; float a = 0.f;
#pragma unroll 8
        for (int k = 0; k < 32; ++k) a += am[(32 + i) * 68 + k] * tm[k * 68 + j];
        m1[e] = a; }
    __syncthreads();
#pragma unroll
    for (int e = 0; e < 2; ++e) tmp[tid + 512 * e] = m1[e];
    __syncthreads();
#pragma unroll
    for (int e = 0; e < 2; ++e) { const int o = tid + 512 * e, i = o >> 5, j = o & 31; float a = 0.f;
#pragma unroll 8
        for (int k = 0; k < 32; ++k) a += tm[(32 + i) * 68 + 32 + k] * tmp[k * 32 + j];
        m1[e] = -a; }
#pragma unroll
    for (int e = 0; e < 2; ++e) { const int o = tid + 512 * e, i = o >> 5, j = o & 31; tm[(32 + i) * 68 + j] = m1[e]; }
    __syncthreads();
    { const int nt = wid & 3, mat = wid >> 2; const float* src = mat ? vf : kf; float* wst = qf;
      f32x16 acc0, acc1;
#pragma unroll
      for (int i = 0; i < 16; ++i) { acc0[i] = 0.f; acc1[i] = 0.f; }
#pragma unroll
      for (int ks = 0; ks < 4; ++ks) { float bv[8];
#pragma unroll
          for (int j = 0; j < 8; ++j) { const int s = ks * 16 + 8 * h + j; bv[j] = src[s * 132 + nt * 32 + r] * (mat ? betas[s] : betas[s] * eGs[s]); }
          const bf16x8 b = pack8(bv[0], bv[1], bv[2], bv[3], bv[4], bv[5], bv[6], bv[7]);
          acc0 = MFMA32(ld8f(tm + r * 68 + ks * 16 + 8 * h), b, acc0);
          acc1 = MFMA32(ld8f(tm + (32 + r) * 68 + ks * 16 + 8 * h), b, acc1); }
      if (mat) {
          unsigned char* d0 = blob + 57344 + ((size_t)((0 * 4 + nt) * 64 + lane)) * 32; unsigned char* d1 = blob + 57344 + ((size_t)((1 * 4 + nt) * 64 + lane)) * 32;
          *(bf16x8*)d0 = pack_step(acc0, 0); *(bf16x8*)(d0 + 16) = pack_step(acc0, 1);
          *(bf16x8*)d1 = pack_step(acc1, 0); *(bf16x8*)(d1 + 16) = pack_step(acc1, 1);
      } else {
#pragma unroll
          for (int i = 0; i < 16; ++i) { wst[crow(i, h) * 132 + nt * 32 + r] = -acc0[i]; wst[(32 + crow(i, h)) * 132 + nt * 32 + r] = -acc1[i]; }
      } }
    __syncthreads();
    emit_frags(blob, 2, 8, [&](int row, int col) { return qf[row * 132 + col]; });
    __syncthreads();
}

DI void prep_ml(const Params& p, unsigned char* smem, int cgi, int hd) {
    const int tid = threadIdx.x, lane = tid & 63, wid = tid >> 6, r = lane & 31, h = lane >> 5;
    float* qf = (float*)smem; float* kf = qf + 64 * 132; bf16_t* vb = (bf16_t*)(smem + 67584); float* pm = (float*)(smem + 101376); float* sc = (float*)(smem + 153600);
    float* as_ = sc; float* pms = sc + 64; float* wend = sc + 128;
    const int row0 = cgi * 64; const bf16_t* pa = (const bf16_t*)(p.ws + OFF_PA); const float* gates = (const float*)(p.ws + OFF_GATES);
    unsigned char* blob = (unsigned char*)p.out + DO_PREPM + ((size_t)cgi * 8 + hd) * BLOB;
    for (int idx = tid; idx < 64 * 128; idx += 512) { const int t = idx >> 7, ch = idx & 127;
        qf[t * 132 + ch] = bf2f(pa[(size_t)(row0 + t) * NA + 6144 + hd * 128 + ch]);
        kf[t * 132 + ch] = bf2f(pa[(size_t)(row0 + t) * NA + 7168 + hd * 128 + ch]) * 0.08838834764831845f; }
    for (int idx = tid; idx < 64 * 256; idx += 512) { const int t = idx >> 8, ch = idx & 255; vb[t * 264 + ch] = pa[(size_t)(row0 + t) * NA + 8192 + hd * 256 + ch]; }
    if (tid < 64) {
        const float mi = gates[(size_t)(row0 + tid) * 64 + 32 + hd], mf = gates[(size_t)(row0 + tid) * 64 + 40 + hd];
        const float logi = mi + p.b_i[hd]; const float logf = -softplus_f(-(mf + p.b_f[hd]));
        float b = logf;
#pragma unroll
        for (int o = 1; o < 64; o <<= 1) { const float t2 = __shfl_up(b, o); if (lane >= o) b += t2; }
        const float a = logi - b; float px = a;
#pragma unroll
        for (int o = 1; o < 64; o <<= 1) { const float t2 = __shfl_up(px, o); if (lane >= o) px = fmaxf(px, t2); }
        const float p63 = __shfl(px, 63);
        as_[tid] = a; pms[tid] = px; wend[tid] = expf(a - p63);
        ((float*)(p.ws + OFF_MB))[(size_t)(row0 + tid) * 8 + hd] = b; ((float*)(p.ws + OFF_MDMAX))[(size_t)(row0 + tid) * 8 + hd] = b + px;
    }
    __syncthreads();
    if (wid < 4) {
        const int ti = wid >> 1, tj = wid & 1;
        if (ti == 0 && tj == 1) {
#pragma unroll
            for (int i = 0; i < 16; ++i) pm[crow(i, h) * 68 + 32 + r] = 0.f;
        } else { f32x16 acc;
#pragma unroll
            for (int i = 0; i < 16; ++i) acc[i] = 0.f;
#pragma unroll
            for (int ks = 0; ks < 8; ++ks) acc = MFMA32(ld8f(qf + (ti * 32 + r) * 132 + ks * 16 + h * 8), ld8f(kf + (tj * 32 + r) * 132 + ks * 16 + h * 8), acc);
#pragma unroll
            for (int i = 0; i < 16; ++i) { const int t = ti * 32 + crow(i, h), s = tj * 32 + r; pm[t * 68 + s] = (s <= t) ? acc[i] * __expf(as_[s] - pms[t]) : 0.f; }
        }
    } else if (tid < 256 + 128) { const int k = tid - 256; float a = 0.f;
        for (int s = 0; s < 64; ++s) a += wend[s] * kf[s * 132 + k];
        ((float*)(p.ws + OFF_KN))[((size_t)cgi * 8 + hd) * 128 + k] = a; }
    emit_frags(blob, 2, 8, [&](int row, int col) { return qf[row * 132 + col]; });
    emit_frags(blob + 24576, 4, 4, [&](int row, int col) { return kf[col * 132 + row] * wend[col]; });
    for (int idx = tid; idx < 8 * 4 * 64; idx += 512) { const int f = idx >> 6, l = idx & 63, nt = f >> 2, ks = f & 3, c = l & 31, hh = l >> 5;
        const int sb = (ks >> 1) * 32 + (ks & 1) * 16 + 4 * hh; bf16x8 o;
#pragma unroll
        for (int j = 0; j < 8; ++j) o[j] = (short)vb[(sb + 8 * (j >> 2) + (j & 3)) * 264 + nt * 32 + c];
        *(bf16x8*)(blob + 40960 + (size_t)idx * 16) = o; }
    __syncthreads();
    if (tid < 64) { float a = 0.f; for (int s = 0; s < 64; ++s) a += pm[tid * 68 + s]; ((float*)(p.ws + OFF_MRS))[(size_t)(row0 + tid) * 8 + hd] = a; }
    emit_frags(blob + 16384, 2, 4, [&](int row, int col) { return pm[row * 68 + col]; });
    __syncthreads();
}

DI void lds_copy_kb(LAS unsigned char* lbuf, const unsigned char* g, int nkb, int wid, int lane) {
    for (int kb = wid; kb < nkb; kb += 8)
        __builtin_amdgcn_global_load_lds((const unsigned*)(g + (size_t)kb * 1024 + lane * 16), (LAS unsigned*)(lbuf + kb * 1024), 16, 0, 0);
}
#define WAIT_ALL_VM() asm volatile("s_waitcnt vmcnt(0)" ::: "memory")

DI void scan_gdn(const Params& p, unsigned char* smem, int seq, int hd) {
    const int tid = threadIdx.x, lane = tid & 63, wid = __builtin_amdgcn_readfirstlane(tid >> 6), r = lane & 31, h = lane >> 5, w = wid;
    const int nch = seq < 2 ? 128 : 1, cg0 = seq < 2 ? seq * 128 : 256 + (seq - 2);
    LAS unsigned char* lds = (LAS unsigned char*)smem;
    const unsigned char* blob0 = p.ws + OFF_PREPG + ((size_t)cg0 * 16 + hd) * BLOB;
    const float* egl = (const float*)(p.ws + OFF_EGL); bf16_t* oraw = (bf16_t*)(p.ws + OFF_ORAW);
    f32x16 S[4];
    __syncthreads();
    const int sbase = (4 * h * 128 + 32 * (w & 3) + r) * 4;
    if (seq >= 2) {
        lds_copy_kb(lds + BLOB, (const unsigned char*)(p.sg + ((size_t)(seq - 2) * 16 + hd) * 16384), 64, wid, lane);
        WAIT_ALL_VM(); __syncthreads();
#pragma unroll
        for (int kt = 0; kt < 4; ++kt)
#pragma unroll
            for (int i = 0; i < 16; ++i) S[kt][i] = *(const LAS float*)(lds + BLOB + sbase + (32 * kt + (i & 3) + 8 * (i >> 2)) * 512);
    } else {
#pragma unroll
        for (int kt = 0; kt < 4; ++kt)
#pragma unroll
            for (int i = 0; i < 16; ++i) S[kt][i] = 0.f;
    }
    __syncthreads();
    lds_copy_kb(lds, blob0, 72, wid, lane);
    float eg_next = egl[cg0 * 16 + hd];
    WAIT_ALL_VM(); __syncthreads();
    for (int c = 0; c < nch; ++c) {
        const int cur = c & 1; const float eg = eg_next;
        if (c + 1 < nch) { lds_copy_kb(lds + (cur ^ 1) * BLOB, blob0 + (size_t)(c + 1) * 16 * BLOB, 72, wid, lane); eg_next = egl[(cg0 + c + 1) * 16 + hd]; }
        if (w < 4) {
            const LAS unsigned char* buf = lds + cur * BLOB;
            f32x16 U[2], O[2];
#pragma unroll
            for (int mt = 0; mt < 2; ++mt) {
                const LAS bf16x8* up = (const LAS bf16x8*)(buf + 57344 + ((mt * 4 + w) * 64 + lane) * 32);
                const bf16x8 u0 = up[0], u1 = up[1];
#pragma unroll
                for (int i = 0; i < 8; ++i) { U[mt][i] = bf2f((bf16_t)u0[i]); U[mt][8 + i] = bf2f((bf16_t)u1[i]); O[mt][i] = 0.f; O[mt][8 + i] = 0.f; }
            }
#pragma unroll
            for (int ks = 0; ks < 8; ++ks) { const bf16x8 sf = pack_step(S[ks >> 1], ks & 1);
#pragma unroll
                for (int mt = 0; mt < 2; ++mt) {
                    U[mt] = MFMA32(*(const LAS bf16x8*)(buf + ((mt * 8 + ks) * 64 + lane) * 16), sf, U[mt]);
                    O[mt] = MFMA32(*(const LAS bf16x8*)(buf + (((mt + 2) * 8 + ks) * 64 + lane) * 16), sf, O[mt]); }
            }
#pragma unroll
            for (int kt = 0; kt < 4; ++kt)
#pragma unroll
                for (int i = 0; i < 16; ++i) S[kt][i] *= eg;
#pragma unroll
            for (int ks = 0; ks < 4; ++ks) { const bf16x8 uf = pack_step(U[ks >> 1], ks & 1);
#pragma unroll
                for (int mt = 0; mt < 2; ++mt) O[mt] = MFMA32(*(const LAS bf16x8*)(buf + 32768 + ((mt * 4 + ks) * 64 + lane) * 16), uf, O[mt]);
#pragma unroll
                for (int kt = 0; kt < 4; ++kt) S[kt] = MFMA32(*(const LAS bf16x8*)(buf + 40960 + ((kt * 4 + ks) * 64 + lane) * 16), uf, S[kt]);
            }
            unsigned long long ob = (unsigned long long)(oraw + ((size_t)(cg0 + c) * 64 + 4 * h) * 2048 + hd * 128 + 32 * w + r);
            asm volatile("" : "+v"(ob));
#pragma unroll
            for (int mt = 0; mt < 2; ++mt)
#pragma unroll
                for (int i = 0; i < 16; ++i) *(bf16_t*)(ob + (size_t)(32 * mt + (i & 3) + 8 * (i >> 2)) * 4096) = f2bf(O[mt][i]);
        }
        WAIT_ALL_VM(); __syncthreads();
    }
    {   float* dst = p.out + (seq < 2 ? O_GDN_P + ((size_t)seq * 16 + hd) * 16384 : O_GDN_S + ((size_t)(seq - 2) * 16 + hd) * 16384);
        if (w < 4) {
#pragma unroll
            for (int kt = 0; kt < 4; ++kt)
#pragma unroll
                for (int i = 0; i < 16; ++i) *(LAS float*)(lds + sbase + (32 * kt + (i & 3) + 8 * (i >> 2)) * 512) = S[kt][i];
        }
        __syncthreads();
        for (int i = tid; i < 4096; i += 512) *(f32x4*)(dst + i * 4) = *(const LAS f32x4*)(lds + i * 16);
        __syncthreads();
    }
}

DI void scan_ml(const Params& p, unsigned char* smem, int seq, int hd, int half) {
    const int tid = threadIdx.x, lane = tid & 63, wid = __builtin_amdgcn_readfirstlane(tid >> 6), r = lane & 31, h = lane >> 5, w = wid;
    const int nch = seq < 2 ? 128 : 1, cg0 = seq < 2 ? seq * 128 : 256 + (seq - 2);
    LAS unsigned char* lds = (LAS unsigned char*)smem; float* scr = (float*)(smem + 147456) + wid * 128;
    const unsigned char* blob0 = (const unsigned char*)p.out + DO_PREPM + ((size_t)cg0 * 8 + hd) * BLOB;
    bf16_t* num = (bf16_t*)((unsigned char*)p.out + DO_NUM);
    const float* mbp = (const float*)(p.ws + OFF_MB); const float* mdp = (const float*)(p.ws + OFF_MDMAX); const float* knp = (const float*)(p.ws + OFF_KN);
    float* ncs = (float*)(p.ws + OFF_NCS); float* mcs = (float*)(p.ws + OFF_MCS);
    const bool nwave = (w == 4) && (half == 0);
    f32x16 C[4]; float m = 0.f, n0 = 0.f, n1 = 0.f;
    if (seq >= 2) { m = p.sm[(seq - 2) * 8 + hd];
        if (nwave) { n0 = p.sn[((size_t)(seq - 2) * 8 + hd) * 128 + lane]; n1 = p.sn[((size_t)(seq - 2) * 8 + hd) * 128 + 64 + lane]; } }
    __syncthreads();
    const int sbase = (4 * h * 128 + 32 * (w & 3) + r) * 4;
    if (seq >= 2) {
        const unsigned char* C0 = (const unsigned char*)(p.sc + ((size_t)(seq - 2) * 8 + hd) * 32768) + half * 512;
        for (int kb = wid; kb < 64; kb += 8)
            __builtin_amdgcn_global_load_lds((const unsigned*)(C0 + (size_t)(2 * kb + (lane >> 5)) * 1024 + (lane & 31) * 16), (LAS unsigned*)(lds + BLOB + kb * 1024), 16, 0, 0);
        WAIT_ALL_VM(); __syncthreads();
#pragma unroll
        for (int kt = 0; kt < 4; ++kt)
#pragma unroll
            for (int i = 0; i < 16; ++i) C[kt][i] = *(const LAS float*)(lds + BLOB + sbase + (32 * kt + (i & 3) + 8 * (i >> 2)) * 512);
    } else {
#pragma unroll
        for (int kt = 0; kt < 4; ++kt)
#pragma unroll
            for (int i = 0; i < 16; ++i) C[kt][i] = 0.f;
    }
    __syncthreads();
    lds_copy_kb(lds, blob0, 40, wid, lane); lds_copy_kb(lds + 40960, blob0 + 40960 + half * 16384, 16, wid, lane);
    float bt_n = mbp[((size_t)cg0 * 64 + lane) * 8 + hd], dm_n = mdp[((size_t)cg0 * 64 + lane) * 8 + hd];
    float k0_n = 0.f, k1_n = 0.f;
    if (nwave) { k0_n = knp[((size_t)cg0 * 8 + hd) * 128 + lane]; k1_n = knp[((size_t)cg0 * 8 + hd) * 128 + 64 + lane]; }
    WAIT_ALL_VM(); __syncthreads();
    for (int c = 0; c < nch; ++c) {
        const int cur = c & 1; const int cgi = cg0 + c;
        const float bt = bt_n, dm = dm_n, k0 = k0_n, k1 = k1_n;
        if (c + 1 < nch) { const unsigned char* bl = blob0 + (size_t)(c + 1) * 8 * BLOB;
            lds_copy_kb(lds + (cur ^ 1) * BLOB, bl, 40, wid, lane); lds_copy_kb(lds + (cur ^ 1) * BLOB + 40960, bl + 40960 + half * 16384, 16, wid, lane);
            bt_n = mbp[((size_t)(cgi + 1) * 64 + lane) * 8 + hd]; dm_n = mdp[((size_t)(cgi + 1) * 64 + lane) * 8 + hd];
            if (nwave) { k0_n = knp[((size_t)(cgi + 1) * 8 + hd) * 128 + lane]; k1_n = knp[((size_t)(cgi + 1) * 8 + hd) * 128 + 64 + lane]; } }
        const float bL = __shfl(bt, 63), E = __shfl(dm, 63);
        const float inter = bt + m, mtv = fmaxf(inter, dm), wq = __expf(inter - mtv), rr = __expf(dm - mtv);
        const float m_new = __shfl(mtv, 63), wC = __expf(bL + m - m_new), sE = __expf(E - m_new);
        if (w < 4) {
            const LAS unsigned char* buf = lds + cur * BLOB;
            scr[lane] = wq; scr[64 + lane] = rr;
            bf16x8 Vf[4];
#pragma unroll
            for (int ks = 0; ks < 4; ++ks) Vf[ks] = *(const LAS bf16x8*)(buf + 40960 + ((w * 4 + ks) * 64 + lane) * 16);
            unsigned long long ob = (unsigned long long)(num + ((size_t)cgi * 64 + 4 * h) * 2048 + hd * 256 + half * 128 + 32 * w + r);
            asm volatile("" : "+v"(ob));
            const float* scrh = scr + 4 * h;
            f32x16 QC[2];
#pragma unroll
            for (int i = 0; i < 16; ++i) { QC[0][i] = 0.f; QC[1][i] = 0.f; }
#pragma unroll
            for (int ks = 0; ks < 8; ++ks) { const bf16x8 cf = pack_step(C[ks >> 1], ks & 1);
#pragma unroll
                for (int mt = 0; mt < 2; ++mt) QC[mt] = MFMA32(*(const LAS bf16x8*)(buf + ((mt * 8 + ks) * 64 + lane) * 16), cf, QC[mt]); }
#pragma unroll
            for (int mt = 0; mt < 2; ++mt) { f32x16 PV;
#pragma unroll
                for (int i = 0; i < 16; ++i) PV[i] = 0.f;
#pragma unroll
                for (int ks = 0; ks < 4; ++ks) PV = MFMA32(*(const LAS bf16x8*)(buf + 16384 + ((mt * 4 + ks) * 64 + lane) * 16), Vf[ks], PV);
#pragma unroll
                for (int i = 0; i < 16; ++i) { const int t0 = 32 * mt + (i & 3) + 8 * (i >> 2);
                    *(bf16_t*)(ob + (size_t)t0 * 4096) = f2bf(scrh[t0] * QC[mt][i] + scrh[64 + t0] * PV[i]); }
            }
#pragma unroll
            for (int kt = 0; kt < 4; ++kt) { f32x16 dC;
#pragma unroll
                for (int i = 0; i < 16; ++i) dC[i] = 0.f;
#pragma unroll
                for (int ks = 0; ks < 4; ++ks) dC = MFMA32(*(const LAS bf16x8*)(buf + 24576 + ((kt * 4 + ks) * 64 + lane) * 16), Vf[ks], dC);
#pragma unroll
                for (int i = 0; i < 16; ++i) C[kt][i] = wC * C[kt][i] + sE * dC[i]; }
        } else if (nwave) {
            ncs[((size_t)cgi * 8 + hd) * 128 + lane] = n0; ncs[((size_t)cgi * 8 + hd) * 128 + 64 + lane] = n1;
            if (lane == 0) mcs[cgi * 8 + hd] = m;
            n0 = wC * n0 + sE * k0; n1 = wC * n1 + sE * k1;
        }
        m = m_new;
        WAIT_ALL_VM(); __syncthreads();
    }
    {   float* dst = p.out + (seq < 2 ? O_C_P + ((size_t)seq * 8 + hd) * 32768 : O_C_S + ((size_t)(seq - 2) * 8 + hd) * 32768) + half * 128;
        if (w < 4) {
#pragma unroll
            for (int kt = 0; kt < 4; ++kt)
#pragma unroll
                for (int i = 0; i < 16; ++i) *(LAS float*)(lds + sbase + (32 * kt + (i & 3) + 8 * (i >> 2)) * 512) = C[kt][i];
        }
        __syncthreads();
        for (int i = tid; i < 4096; i += 512) *(f32x4*)(dst + (i >> 5) * 256 + (i & 31) * 4) = *(const LAS f32x4*)(lds + i * 16);
        __syncthreads();
    }
    if (nwave) {
        float* dn = p.out + (seq < 2 ? O_N_P + ((size_t)seq * 8 + hd) * 128 : O_N_S + ((size_t)(seq - 2) * 8 + hd) * 128);
        dn[lane] = n0; dn[64 + lane] = n1;
        if (lane == 0) p.out[(seq < 2 ? O_M_P + seq * 8 + hd : O_M_S + (seq - 2) * 8 + hd)] = m;
    }
}

DI void phase3(const Params& p, unsigned char* smem) {
    const int b = blockIdx.x;
    if (b < 32) scan_gdn(p, smem, b >> 4, b & 15);
    else if (b < 64) { const int i = b - 32; scan_ml(p, smem, i >> 4, (i >> 1) & 7, i & 1); }
    else {
        for (int it = b - 64; it < 1024; it += gridDim.x - 64) {
            if (it < 512) scan_gdn(p, smem, 2 + (it >> 4), it & 15);
            else { const int i = it - 512; scan_ml(p, smem, 2 + (i >> 4), (i >> 1) & 7, i & 1); }
            __syncthreads();
        }
    }
}

DI void phase4(const Params& p) {
    const int tid = threadIdx.x, lane = tid & 63, wid = tid >> 6;
    const int gw = blockIdx.x * 8 + wid, nw = gridDim.x * 8;
    const bf16_t* oraw = (const bf16_t*)(p.ws + OFF_ORAW); const bf16_t* num = (const bf16_t*)((const unsigned char*)p.out + DO_NUM);
    const bf16_t* pa = (const bf16_t*)(p.ws + OFF_PA); const bf16_t* pb = (const bf16_t*)(p.ws + OFF_PB);
    const float* mbp = (const float*)(p.ws + OFF_MB); const float* mdp = (const float*)(p.ws + OFF_MDMAX); const float* mrs = (const float*)(p.ws + OFF_MRS);
    const float* ncs = (const float*)(p.ws + OFF_NCS); const float* mcs = (const float*)(p.ws + OFF_MCS);
    bf16_t* mixed = (bf16_t*)(p.ws + OFF_MIXED);
    const float gw0 = p.gdn_nw[2 * lane], gw1 = p.gdn_nw[2 * lane + 1];
    const f32x4 mw = *(const f32x4*)(p.ml_nw + 4 * lane);
    for (int row = gw; row < NTOK; row += nw) {
        const int cgi = row >> 6;
        for (int hd = 0; hd < 16; ++hd) {
            const unsigned ov = *(const unsigned*)(oraw + (size_t)row * 2048 + hd * 128 + 2 * lane);
            const unsigned zv = *(const unsigned*)(pb + (size_t)row * NB + hd * 128 + 2 * lane);
            const float o0 = __uint_as_float(ov << 16), o1 = __uint_as_float(ov & 0xffff0000u), z0 = __uint_as_float(zv << 16), z1 = __uint_as_float(zv & 0xffff0000u);
            const float rs = rsqrtf(wave_sum(o0 * o0 + o1 * o1) * (1.f / 128.f) + 1e-6f);
            *(unsigned*)(mixed + (size_t)row * DM + hd * 128 + 2 * lane) = pk2(o0 * rs * gw0 * silu_f(z0), o1 * rs * gw1 * silu_f(z1));
        }
        for (int hd = 0; hd < 8; ++hd) {
            const float mc = mcs[cgi * 8 + hd], bt = mbp[(size_t)row * 8 + hd], dm = mdp[(size_t)row * 8 + hd], rsm = mrs[(size_t)row * 8 + hd];
            const float inter = bt + mc, mtv = fmaxf(inter, dm), wq = __expf(inter - mtv), rr = __expf(dm - mtv);
            const unsigned qv = *(const unsigned*)(pa + (size_t)row * NA + 6144 + hd * 128 + 2 * lane);
            const float2 nv = *(const float2*)(ncs + ((size_t)cgi * 8 + hd) * 128 + 2 * lane);
            const float qn = wave_sum(__uint_as_float(qv << 16) * nv.x + __uint_as_float(qv & 0xffff0000u) * nv.y);
            const float den = wq * qn + rr * rsm; const float inv = 1.f / fmaxf(fabsf(den), __expf(-mtv));
            const uint2 nm = *(const uint2*)(num + (size_t)row * 2048 + hd * 256 + 4 * lane);
            const float h0 = __uint_as_float(nm.x << 16) * inv, h1 = __uint_as_float(nm.x & 0xffff0000u) * inv, h2 = __uint_as_float(nm.y << 16) * inv, h3 = __uint_as_float(nm.y & 0xffff0000u) * inv;
            const float rs = rsqrtf(wave_sum(h0 * h0 + h1 * h1 + h2 * h2 + h3 * h3) * (1.f / 256.f) + 1e-6f);
            const uint2 ov = *(const uint2*)(pb + (size_t)row * NB + 2048 + hd * 256 + 4 * lane);
            const uint2 zv = *(const uint2*)(pb + (size_t)row * NB + 4096 + hd * 256 + 4 * lane);
            const float g0 = sigm_f(__uint_as_float(ov.x << 16)) * silu_f(__uint_as_float(zv.x << 16)), g1 = sigm_f(__uint_as_float(ov.x & 0xffff0000u)) * silu_f(__uint_as_float(zv.x & 0xffff0000u));
            const float g2 = sigm_f(__uint_as_float(ov.y << 16)) * silu_f(__uint_as_float(zv.y << 16)), g3 = sigm_f(__uint_as_float(ov.y & 0xffff0000u)) * silu_f(__uint_as_float(zv.y & 0xffff0000u));
            uint2 o; o.x = pk2(h0 * rs * mw[0] * g0, h1 * rs * mw[1] * g1); o.y = pk2(h2 * rs * mw[2] * g2, h3 * rs * mw[3] * g3);
            *(uint2*)(mixed + (size_t)row * DM + 2048 + hd * 256 + 4 * lane) = o;
        }
    }
    for (int i = blockIdx.x * 512 + tid; i < 34 * 3 * 6144; i += gridDim.x * 512) {
        const int c = i % 6144, j = (i / 6144) % 3, s = i / (3 * 6144);
        const size_t row = s < 2 ? (size_t)s * 8192 + 8189 + j : (size_t)NPR + (size_t)(s - 2) * 64 + 61 + j;
        const float v = bf2f(pa[row * NA + c]);
        if (s < 2) p.out[O_CONV_P + ((size_t)s * 3 + j) * 6144 + c] = v; else p.out[O_CONV_S + ((size_t)(s - 2) * 3 + j) * 6144 + c] = v;
    }
}

DI void phase6(const Params& p) {
    const int tid = threadIdx.x, lane = tid & 63, wid = tid >> 6;
    const int gw = blockIdx.x * 8 + wid, nw = gridDim.x * 8;
    const float* rowss = (const float*)(p.ws + OFF_ROWSS);
    for (int row = gw; row < NTOK; row += nw) {
        float* yr = p.out + (size_t)row * DM; const float rs = rsqrtf(rowss[row] * (1.f / DM) + 1e-6f);
#pragma unroll
        for (int i = 0; i < 16; ++i) { const f32x4 g = *(const f32x4*)(p.final_g + (lane + 64 * i) * 4); f32x4 v = *(const f32x4*)(yr + (lane + 64 * i) * 4);
            v[0] *= rs * g[0]; v[1] *= rs * g[1]; v[2] *= rs * g[2]; v[3] *= rs * g[3]; *(f32x4*)(yr + (lane + 64 * i) * 4) = v; }
    }
}

DI void phase1(const Params& p, unsigned char* smem) {
    pg8::Gemm g; g.A = (const bf16_t*)(p.ws + OFF_H); g.Bt = (const bf16_t*)(p.ws + OFF_BT1); g.M = NTOK; g.N = N1; g.K = DM;
    pg8::StaticOrder S; S.init(g.M, g.N, (int)gridDim.x, (int)blockIdx.x);
    Epi1 E; E.pa = (bf16_t*)(p.ws + OFF_PA); E.pb = (bf16_t*)(p.ws + OFF_PB); E.gates = (float*)(p.ws + OFF_GATES);
    pg8::gemm_phase<Epi1, pg8::StaticOrder, false>((LAS unsigned char*)smem, g, S, E, nullptr);
    __syncthreads();
}
DI void phase2(const Params& p, unsigned char* smem) {
    for (int it = blockIdx.x; it < 6912; it += gridDim.x) { if (it < 4608) prep_gdn(p, smem, it >> 4, it & 15); else prep_ml(p, smem, (it - 4608) >> 3, (it - 4608) & 7); }
}
DI void phase5(const Params& p, unsigned char* smem) {
    pg8::Gemm g; g.A = (const bf16_t*)(p.ws + OFF_MIXED); g.Bt = (const bf16_t*)(p.ws + OFF_BT2); g.M = NTOK; g.N = DM; g.K = DM;
    pg8::StaticOrder S; S.init(g.M, g.N, (int)gridDim.x, (int)blockIdx.x);
    Epi2 E; E.xp = p.xp; E.xs = p.xs; E.y = p.out; E.rowss = (float*)(p.ws + OFF_ROWSS);
    pg8::gemm_phase<Epi2, pg8::StaticOrder, false>((LAS unsigned char*)smem, g, S, E, nullptr);
    __syncthreads();
}

__global__ __launch_bounds__(512, 2) void mega(Params p) {
    extern __shared__ __attribute__((aligned(16))) unsigned char smem[];
    cg::grid_group grid = cg::this_grid();
#ifndef PHMASK
#define PHMASK 127
#endif
#define PHASE(i, call) if constexpr ((PHMASK >> (i)) & 1) { if (p.ph_lo <= (i) && (i) <= p.ph_hi) { call; if ((i) < p.ph_hi) grid.sync(); } }
    PHASE(0, phase0(p, smem))
    PHASE(1, phase1(p, smem))
    PHASE(2, phase2(p, smem))
    PHASE(3, phase3(p, smem))
    PHASE(4, phase4(p))
    PHASE(5, phase5(p, smem))
    PHASE(6, phase6(p))
}

#ifndef N_LAUNCH_SPLIT
#define N_LAUNCH_SPLIT 1
#endif
extern "C" void kernel_launch(void* const* d_in, const int* in_sizes, int n_in, void* d_out, int out_size, void* d_ws, size_t ws_size, hipStream_t stream) {
    static int grid = 0;
    if (grid == 0) {
        if (ws_size < WS_END || n_in != 18) { fprintf(stderr, "kernel_launch: workspace %zu < %zu or n_in %d != 18\n", ws_size, (size_t)WS_END, n_in); grid = -1; return; }
        int dev = 0, cus = 0, per_cu = 0;
        (void)hipGetDevice(&dev); (void)hipDeviceGetAttribute(&cus, hipDeviceAttributeMultiprocessorCount, dev);
        (void)hipFuncSetAttribute((const void*)mega, hipFuncAttributeMaxDynamicSharedMemorySize, LDS_BYTES);
        (void)hipOccupancyMaxActiveBlocksPerMultiprocessor(&per_cu, (const void*)mega, 512, LDS_BYTES);
        if (per_cu < 1) { fprintf(stderr, "kernel_launch: occupancy query says %d blocks/CU\n", per_cu); per_cu = 1; }
        (void)hipGetLastError();
        grid = cus;
    }
    if (grid < 0) return;
    Params p{};
    p.xp = (const float*)d_in[0]; p.xs = (const float*)d_in[1]; p.cache = (const float*)d_in[2]; p.sg = (const float*)d_in[3]; p.sc = (const float*)d_in[4];
    p.sn = (const float*)d_in[5]; p.sm = (const float*)d_in[6]; p.norm_g = (const float*)d_in[7]; p.w_in = (const float*)d_in[8]; p.conv_w = (const float*)d_in[9];
    p.a_log = (const float*)d_in[10]; p.dt_bias = (const float*)d_in[11]; p.gdn_nw = (const float*)d_in[12]; p.b_i = (const float*)d_in[13]; p.b_f = (const float*)d_in[14];
    p.ml_nw = (const float*)d_in[15]; p.w_out = (const float*)d_in[16]; p.final_g = (const float*)d_in[17];
    p.out = (float*)d_out; p.ws = (unsigned char*)d_ws;
#if N_LAUNCH_SPLIT == 1
    p.ph_lo = 0; p.ph_hi = 6;
    void* args[] = {&p};
    hipError_t e = hipLaunchCooperativeKernel((const void*)mega, dim3(grid), dim3(512), args, LDS_BYTES, stream);
    if (e != hipSuccess) fprintf(stderr, "cooperative launch failed: %s (grid %d)\n", hipGetErrorString(e), grid);
#else
    for (int ph = 0; ph <= 6; ++ph) { p.ph_lo = ph; p.ph_hi = ph; hipLaunchKernelGGL(mega, dim3(grid), dim3(512), LDS_BYTES, stream, p); }
#endif
}
```

```cpp
#include <hip/hip_runtime.h>
#include <hip/hip_cooperative_groups.h>
#include <cstdio>
namespace cg = cooperative_groups;
#define N_LAUNCH_SPLIT 1
#define DBLMASK 0
namespace pg8 {
#define PG8_LAS __attribute__((address_space(3)))
typedef unsigned short bf16_t;
typedef short bf16x8 __attribute__((ext_vector_type(8)));
typedef float f32x4 __attribute__((ext_vector_type(4)));
typedef unsigned u32x4 __attribute__((ext_vector_type(4)));
constexpr int BM = 256, BK = 64, HALF = 128, HTB = HALF * BK * 2  , STAGE_BYTES = 8 * HTB, NXCD = 8, WGM = 8;

__host__ __device__ __forceinline__ int lds_byte(int r, int c) { const int st = (r >> 4) * 2 + (c >> 5), rr = r & 15, cc = c & 31, ob = rr * 64 + cc * 2; return st * 1024 + (ob ^ (((ob >> 9) & 1) << 5)); }
__host__ __device__ __forceinline__ void stage_rc(int b, int& R, int& C) { const int st = b / 1024, sb = b % 1024, swz = sb ^ (((sb >> 9) & 1) << 5); R = (st >> 1) * 16 + swz / 64; C = (st & 1) * 32 + (swz % 64) / 2; }
__host__ __device__ __forceinline__ int perm32(int rho) { const int n = rho >> 4, i = rho & 15; return 8 * (i >> 2) + 4 * n + (i & 3); }

struct Unit { int pm, pn; };
struct Gemm { const bf16_t* A; const bf16_t* Bt; int M, N, K; };

struct StaticOrder {
    int nM, nN, nwg, G, c;
    __host__ __device__ void init(int M, int N, int G_, int c_) { nM = M / BM; nN = N / BM; nwg = nM * nN; G = G_; c = c_; }
    __host__ __device__ bool next(int i, Unit& u) const {
        const long L = (long)i * G + c; if (L >= nwg) return false;
        int wgid = (int)L; { const int q = nwg / NXCD, r = nwg % NXCD, xcd = wgid % NXCD, off = wgid / NXCD; wgid = (xcd < r ? xcd * (q + 1) : r * (q + 1) + (xcd - r) * q) + off; }
        const int nig = WGM * nN, gid = wgid / nig, fm = gid * WGM, gsz = (nM - fm) < WGM ? (nM - fm) : WGM;
        u.pm = fm + ((wgid % nig) % gsz); u.pn = (wgid % nig) / gsz; return true;
    }
    __device__ __forceinline__ void a_ready(const Unit&) const {}
    __device__ __forceinline__ void done(const Unit&) const {}
};
template <class Epi, class Sched, bool STAMP = false>
__device__ __forceinline__ void gemm_phase(PG8_LAS unsigned char* lds, const Gemm g, const Sched& S, const Epi& E, unsigned long long* stamps) {
    const int tid = threadIdx.x, wid = __builtin_amdgcn_readfirstlane(tid >> 6), lane = tid & 63, wr = wid >> 2, wc = wid & 3, fr = lane & 15, fq = lane >> 4;
    const int K = g.K, nt = K / BK;
    int ts_lo = 0, ts_hi = 0, nts = 0; const unsigned long long rt_entry = STAMP ? (unsigned long long)wall_clock64() : 0ull;
#define PG8_STAMP() do { if (STAMP && wid == 0 && nts < 64) { const unsigned long long _c = (unsigned long long)clock64(); \
        ts_lo = (lane == nts) ? (int)(unsigned)_c : ts_lo; ts_hi = (lane == nts) ? (int)(unsigned)(_c >> 32) : ts_hi; ++nts; } } while (0)
    PG8_STAMP();
    unsigned voffA[2], voffB[2];
#pragma unroll
    for (int i = 0; i < 2; ++i) { int R, C; stage_rc(tid * 16 + i * 8192, R, C); const int Rb = Epi::PERM ? ((R & ~31) + perm32(R & 31)) : R;
        voffA[i] = (unsigned)(R * K + C) * 2u; voffB[i] = (unsigned)(Rb * K + C) * 2u; }
    const size_t kstep = (size_t)(BK * 2);
    const size_t hstep = (size_t)HALF * K * 2;
    const size_t tstep = 2 * hstep;
    const unsigned ldsw = (unsigned)wid * 1024u;
    const int aoff = lds_byte(wr * 64 + fr, fq * 8), boff = lds_byte(wc * 32 + fr, fq * 8);
#define PG8_SA(b, h) (((b) * 2 + (h)) * HTB)
#define PG8_SB(b, h) ((4 + (b) * 2 + (h)) * HTB)
#define PG8_STAGE(bufoff, gbase, voff) do { _Pragma("unroll") for (int _i = 0; _i < 2; ++_i) \
        __builtin_amdgcn_global_load_lds((const unsigned*)((const char*)(gbase) + (voff)[_i]), (PG8_LAS unsigned*)(lds + (bufoff) + ldsw + _i * 8192), 16, 0, 0); } while (0)
#define PG8_LDA(dst, b, h) do { _Pragma("unroll") for (int m = 0; m < 4; ++m) _Pragma("unroll") for (int k = 0; k < 2; ++k) dst[m][k] = *(const PG8_LAS bf16x8*)(lds + PG8_SA(b, h) + aoff + m * 2048 + k * 1024); } while (0)
#define PG8_LDB(dst, b, h) do { _Pragma("unroll") for (int n = 0; n < 2; ++n) _Pragma("unroll") for (int k = 0; k < 2; ++k) dst[n][k] = *(const PG8_LAS bf16x8*)(lds + PG8_SB(b, h) + boff + n * 2048 + k * 1024); } while (0)
#define PG8_MMA(ai, bj, At, Bt) do { __builtin_amdgcn_s_setprio(1); _Pragma("unroll") for (int m = 0; m < 4; ++m) _Pragma("unroll") for (int n = 0; n < 2; ++n) _Pragma("unroll") for (int k = 0; k < 2; ++k) \
        acc[ai][bj][m][n] = __builtin_amdgcn_mfma_f32_16x16x32_bf16(Bt[n][k], At[m][k], acc[ai][bj][m][n], 0, 0, 0); __builtin_amdgcn_s_setprio(0); } while (0)
#define PG8_WAIT_V(n) asm volatile("s_waitcnt vmcnt(" #n ")" ::: "memory")
#define PG8_WAIT_L(n) asm volatile("s_waitcnt lgkmcnt(" #n ")" ::: "memory")
#define PG8_BAR __builtin_amdgcn_s_barrier()
#define PG8_SCHED __builtin_amdgcn_sched_barrier(0)
    Unit cur, nxt; int ui = 0;
    if (!S.next(0, cur)) return;
    f32x4 acc[2][2][4][2];
#pragma unroll
    for (int a = 0; a < 2; ++a)
#pragma unroll
        for (int b = 0; b < 2; ++b)
#pragma unroll
            for (int m = 0; m < 4; ++m)
#pragma unroll
                for (int n = 0; n < 2; ++n) acc[a][b][m][n] = (f32x4){0.f, 0.f, 0.f, 0.f};
    bf16x8 At[4][2], B0[2][2], B1[2][2];
    const char* cA = (const char*)g.A + (size_t)cur.pm * tstep; const char* cB = (const char*)g.Bt + (size_t)cur.pn * tstep;
    S.a_ready(cur);
    PG8_STAGE(PG8_SB(0, 0), cB, voffB); PG8_STAGE(PG8_SA(0, 0), cA, voffA); PG8_STAGE(PG8_SB(0, 1), cB + hstep, voffB); PG8_STAGE(PG8_SA(0, 1), cA + hstep, voffA);
    if (wr == 1) PG8_BAR;
    PG8_WAIT_V(4); PG8_BAR;
    PG8_STAGE(PG8_SB(1, 0), cB + kstep, voffB); PG8_STAGE(PG8_SA(1, 0), cA + kstep, voffA); PG8_STAGE(PG8_SB(1, 1), cB + hstep + kstep, voffB);
    PG8_WAIT_V(6); PG8_BAR;
    PG8_STAMP();
    for (;;) {
        const bool has_next = S.next(ui + 1, nxt);
        const char* nA = has_next ? (const char*)g.A + (size_t)nxt.pm * tstep : cA; const char* nB = has_next ? (const char*)g.Bt + (size_t)nxt.pn * tstep : cB;
        for (int t = 0; t < nt; t += 2) {
            const bool last = (t == nt - 2);
            const char* a1 = cA + (size_t)(t + 1) * kstep;
            const char* a2 = last ? nA : cA + (size_t)(t + 2) * kstep; const char* b2 = last ? nB : cB + (size_t)(t + 2) * kstep;
            const char* a3 = a2 + kstep; const char* b3 = b2 + kstep;
            if (last && has_next) S.a_ready(nxt);
            PG8_LDB(B0, 0, 0); PG8_SCHED; PG8_LDA(At, 0, 0); PG8_STAGE(PG8_SA(1, 1), a1 + hstep, voffA);
            PG8_WAIT_L(8); PG8_BAR; PG8_WAIT_L(0); PG8_MMA(0, 0, At, B0); PG8_BAR; PG8_SCHED;
            PG8_LDB(B1, 0, 1); PG8_STAGE(PG8_SB(0, 0), b2, voffB);
            PG8_BAR; PG8_WAIT_L(0); PG8_MMA(0, 1, At, B1); PG8_BAR;
            PG8_LDA(At, 0, 1); PG8_STAGE(PG8_SA(0, 0), a2, voffA);
            PG8_BAR; PG8_WAIT_L(0); PG8_MMA(1, 0, At, B0); PG8_BAR; PG8_SCHED;
            PG8_STAGE(PG8_SB(0, 1), b2 + hstep, voffB);
            PG8_WAIT_V(6); PG8_BAR; PG8_MMA(1, 1, At, B1); PG8_BAR;
            PG8_LDB(B0, 1, 0); PG8_SCHED; PG8_LDA(At, 1, 0); PG8_STAGE(PG8_SA(0, 1), a2 + hstep, voffA);
            PG8_WAIT_L(8); PG8_BAR; PG8_WAIT_L(0); PG8_MMA(0, 0, At, B0); PG8_BAR; PG8_SCHED;
            PG8_LDB(B1, 1, 1); PG8_STAGE(PG8_SB(1, 0), b3, voffB);
            PG8_BAR; PG8_WAIT_L(0); PG8_MMA(0, 1, At, B1); PG8_BAR;
            PG8_LDA(At, 1, 1); PG8_STAGE(PG8_SA(1, 0), a3, voffA);
            PG8_BAR; PG8_WAIT_L(0); PG8_MMA(1, 0, At, B0); PG8_BAR; PG8_SCHED;
            PG8_STAGE(PG8_SB(1, 1), b3 + hstep, voffB);
            PG8_WAIT_V(6); PG8_BAR; PG8_MMA(1, 1, At, B1); PG8_BAR;
        }
        PG8_STAMP();
        if constexpr (!Epi::AFTER_DRAIN) { E(acc, cur, wr, wc, fr, fq); S.done(cur); }
        PG8_STAMP();
        if (!has_next) break;
#pragma unroll
        for (int a = 0; a < 2; ++a)
#pragma unroll
            for (int b = 0; b < 2; ++b)
#pragma unroll
                for (int m = 0; m < 4; ++m)
#pragma unroll
                    for (int n = 0; n < 2; ++n) acc[a][b][m][n] = (f32x4){0.f, 0.f, 0.f, 0.f};
        cur = nxt; cA = nA; cB = nB; ++ui;
    }
    PG8_WAIT_V(0);
    if (wr == 0) PG8_BAR;
    PG8_BAR;
    if constexpr (Epi::AFTER_DRAIN) { E.fused(acc, cur, wr, wc, fr, fq, lds, wid, lane); S.done(cur); }
    PG8_STAMP();
    if (STAMP && wid == 0) { stamps[lane] = lane < nts ? (((unsigned long long)(unsigned)ts_hi << 32) | (unsigned)ts_lo) : 0ull;
        if (lane == 62) stamps[62] = rt_entry; if (lane == 63) stamps[63] = (unsigned long long)wall_clock64(); }
#undef PG8_STAMP
#undef PG8_SA
#undef PG8_SB
#undef PG8_STAGE
#undef PG8_LDA
#undef PG8_LDB
#undef PG8_MMA
#undef PG8_WAIT_V
#undef PG8_WAIT_L
#undef PG8_BAR
#undef PG8_SCHED
}
}
using pg8::bf16_t; using pg8::bf16x8; using pg8::f32x4; using pg8::u32x4;
typedef float f32x16 __attribute__((ext_vector_type(16)));
typedef __bf16 bf16x2_t __attribute__((ext_vector_type(2)));
typedef float f32x2_t __attribute__((ext_vector_type(2)));
#define DI __device__ __forceinline__
#define LAS __attribute__((address_space(3)))
#define GAS __attribute__((address_space(1)))
#define MFMA32(a, b, c) __builtin_amdgcn_mfma_f32_32x32x16_bf16((a), (b), (c), 0, 0, 0)

constexpr int DM = 4096, NTOK = 18432, NPR = 16384, NA = 10240, NB = 6144, N1 = 16640;
constexpr size_t BLOB = 73728;
constexpr size_t OFF_H = 0, OFF_PREPG = 29360128ull, OFF_BT1 = 285212672ull, OFF_MIXED = OFF_PREPG, OFF_BT2 = OFF_MIXED + 150994944ull,
    OFF_PA = OFF_BT1 + 136314880ull, OFF_PB = OFF_PA + (size_t)NTOK * NA * 2, OFF_ORAW0 = OFF_PB + (size_t)NTOK * NB * 2, OFF_ROWSS = OFF_ORAW0 + 9216ull * 4096, WS_END = OFF_ROWSS + 73728;
static_assert(OFF_PREPG + 4608ull * BLOB == OFF_BT1 + 10240ull * 8192, "overlay must end where the protected Bt1 rows start");
constexpr size_t DO_PREPM = 0, DO_NUM = 2304ull * BLOB, DO_ORAW1 = DO_NUM + (size_t)NTOK * 2048 * 2, DO_GATES = DO_ORAW1 + 9216ull * 4096, DO_EGL = DO_GATES + (size_t)NTOK * 64 * 4,
    DO_MB = DO_EGL + 18432, DO_MDMAX = DO_MB + 589824, DO_MRS = DO_MDMAX + 589824, DO_KN = DO_MRS + 589824, DO_NCS = DO_KN + 1179648, DO_MCS = DO_NCS + 1179648,
    DO_TABK = DO_MCS + 9216, DO_TABD = DO_TABK + 18944, DO_END = DO_TABD + 1536;
static_assert(DO_END <= 301989888ull, "d_out scratch must fit in the y region");
constexpr int NKEPT = 4344, NDEF = 336;
constexpr size_t O_Y = 0, O_CONV_P = 75497472ull, O_GDN_P = O_CONV_P + 36864, O_C_P = O_GDN_P + 524288, O_N_P = O_C_P + 524288, O_M_P = O_N_P + 2048,
    O_CONV_S = O_M_P + 16, O_GDN_S = O_CONV_S + 589824, O_C_S = O_GDN_S + 8388608, O_N_S = O_C_S + 8388608, O_M_S = O_N_S + 32768;
constexpr int LDS_BYTES = 155648;

struct Params {
    const float *xp, *xs, *cache, *sg, *sc, *sn, *sm, *norm_g, *w_in, *conv_w, *a_log, *dt_bias, *gdn_nw, *b_i, *b_f, *ml_nw, *w_out, *final_g;
    float* out; unsigned char* ws; int ph_lo, ph_hi, mode3, pad_;
};

DI int gidx(int cgi, int hd) { return cgi < 256 ? (((cgi >> 7) * 16 + hd) * 128 + (cgi & 127)) : (4096 + (cgi - 256) * 16 + hd); }
DI int midx(int cgi, int hd) { return cgi < 256 ? (((cgi >> 7) * 8 + hd) * 128 + (cgi & 127)) : (2048 + (cgi - 256) * 8 + hd); }
DI bf16_t* oraw_blk(const Params& p, int gi) { return gi < 2304 ? (bf16_t*)(p.ws + OFF_ORAW0) + (size_t)gi * 8192 : (bf16_t*)((unsigned char*)p.out + DO_ORAW1) + (size_t)(gi - 2304) * 8192; }
DI float bf2f(bf16_t b) { return __uint_as_float(((unsigned)b) << 16); }
DI unsigned pk2(float a, float b) { f32x2_t v = {a, b}; bf16x2_t r = __builtin_convertvector(v, bf16x2_t); return __builtin_bit_cast(unsigned, r); }
DI bf16_t f2bf(float a) { return (bf16_t)(pk2(a, 0.f) & 0xffffu); }
DI bf16x8 pack8(float a0, float a1, float a2, float a3, float a4, float a5, float a6, float a7) {
    u32x4 p; p[0] = pk2(a0, a1); p[1] = pk2(a2, a3); p[2] = pk2(a4, a5); p[3] = pk2(a6, a7); return __builtin_bit_cast(bf16x8, p); }
DI bf16x8 pack_step(const f32x16& x, int s) { return pack8(x[8 * s], x[8 * s + 1], x[8 * s + 2], x[8 * s + 3], x[8 * s + 4], x[8 * s + 5], x[8 * s + 6], x[8 * s + 7]); }
DI int crow(int reg, int h) { return (reg & 3) + 8 * (reg >> 2) + 4 * h; }
DI float wave_sum(float v) { for (int o = 32; o >= 1; o >>= 1) v += __shfl_xor(v, o); return v; }
DI bf16x8 ld8f(const float* p) { const f32x4 a = *(const f32x4*)p, b = *(const f32x4*)(p + 4); return pack8(a[0], a[1], a[2], a[3], b[0], b[1], b[2], b[3]); }
DI float silu_f(float y) { return y * __builtin_amdgcn_rcpf(1.f + __expf(-y)); }
DI float sigm_f(float y) { return __builtin_amdgcn_rcpf(1.f + __expf(-y)); }
DI float softplus_f(float x) { return fmaxf(x, 0.f) + log1pf(expf(-fabsf(x))); }

DI int emap1(int n) {
    if (n < 6144) return n;
    if (n < 10240) return 8224 + (n - 6144);
    if (n < 12288) return 6144 + (n - 10240);
    if (n < 16384) return 12320 + (n - 12288);
    if (n < 16416) return 8192 + (n - 16384);
    if (n < 16432) return n;
    return -1;
}
DI void transpose_tiles(const Params& p, unsigned char* smem, int tid, bool second) {
    float* tl = (float*)smem;
    bf16_t* dst = (bf16_t*)(p.ws + (second ? OFF_BT2 : OFF_BT1));
    const int NT = second ? 64 * 16 : (N1 / 64) * 16;
    for (int tt = blockIdx.x; tt < NT; tt += gridDim.x) {
        const int n0 = (tt >> 4) * 64, d0 = (tt & 15) * 256;
        const int nn = tid & 63; const int e = second ? (n0 + nn) : emap1(n0 + nn);
        const float* src = second ? p.w_out : p.w_in; const int ld = second ? 4096 : 16432;
        float v[32];
#pragma unroll
        for (int i = 0; i < 32; ++i) { const int dd = (tid >> 6) + 8 * i; v[i] = e >= 0 ? src[(size_t)(d0 + dd) * ld + e] : 0.f; }
#pragma unroll
        for (int i = 0; i < 32; ++i) { const int dd = (tid >> 6) + 8 * i; tl[dd * 65 + nn] = v[i]; }
        __syncthreads();
        const int nn2 = tid >> 3;
#pragma unroll
        for (int j = 0; j < 4; ++j) { const int ds = (tid & 7) * 8 + 64 * j;
            const bf16x8 o = pack8(tl[(ds + 0) * 65 + nn2], tl[(ds + 1) * 65 + nn2], tl[(ds + 2) * 65 + nn2], tl[(ds + 3) * 65 + nn2], tl[(ds + 4) * 65 + nn2], tl[(ds + 5) * 65 + nn2], tl[(ds + 6) * 65 + nn2], tl[(ds + 7) * 65 + nn2]);
            *(bf16x8*)(dst + (size_t)(n0 + nn2) * DM + d0 + ds) = o; }
        __syncthreads();
    }
}
DI void phase0(const Params& p, unsigned char* smem) {
    int tid_ = threadIdx.x; asm volatile("" : "+v"(tid_));
    const int tid = tid_, lane = tid & 63, wid = tid >> 6;
    const int gw = blockIdx.x * 8 + wid, nw = gridDim.x * 8;
    bf16_t* hb = (bf16_t*)(p.ws + OFF_H);
    for (int row = gw; row < NTOK; row += nw) {
        const float* xr = row < NPR ? p.xp + (size_t)row * DM : p.xs + (size_t)(row - NPR) * DM;
        f32x4 v[16]; float ss = 0.f;
#pragma unroll
        for (int i = 0; i < 16; ++i) { v[i] = *(const f32x4*)(xr + (lane + 64 * i) * 4); ss += v[i][0] * v[i][0] + v[i][1] * v[i][1] + v[i][2] * v[i][2] + v[i][3] * v[i][3]; }
        ss = wave_sum(ss);
        const float rs = rsqrtf(ss * (1.f / DM) + 1e-6f);
#pragma unroll
        for (int i = 0; i < 16; ++i) { const f32x4 g = *(const f32x4*)(p.norm_g + (lane + 64 * i) * 4);
            uint2 o; o.x = pk2(v[i][0] * rs * g[0], v[i][1] * rs * g[1]); o.y = pk2(v[i][2] * rs * g[2], v[i][3] * rs * g[3]);
            *(uint2*)(hb + (size_t)row * DM + (lane + 64 * i) * 4) = o; }
    }
    float* rowss = (float*)(p.ws + OFF_ROWSS);
    for (int i = blockIdx.x * 512 + tid; i < NTOK; i += gridDim.x * 512) rowss[i] = 0.f;
    transpose_tiles(p, smem, tid, false);
    if (blockIdx.x == 0 && wid == 0) {
        unsigned* tk = (unsigned*)((unsigned char*)p.out + DO_TABK); unsigned* td = (unsigned*)((unsigned char*)p.out + DO_TABD);
        int nk = 0, nd = 0;
        for (int base = 0; base < 4680; base += 64) { const int wg = base + lane; const bool valid = wg < 4680;
            const int gid = wg / 520, rem = wg - gid * 520, pm = gid * 8 + (rem & 7), pn = rem >> 3;
            const bool def = valid && pn >= 40 && pn < 64 && pm < 14, keep = valid && !def;
            const unsigned long long mk = __ballot(keep), md = __ballot(def); const unsigned long long below = (1ull << lane) - 1ull;
            if (keep) tk[nk + __popcll(mk & below)] = (unsigned)(pm << 8 | pn);
            if (def) td[nd + __popcll(md & below)] = (unsigned)(pm << 8 | pn);
            nk += __popcll(mk); nd += __popcll(md); }
    }
}

struct Epi1 {
    static constexpr bool PERM = true, AFTER_DRAIN = false;
    bf16_t* pa; bf16_t* pb; float* gates;
    DI void operator()(const f32x4 (&acc)[2][2][4][2], const pg8::Unit& u, int wr, int wc, int fr, int fq) const {
        const int row0 = u.pm * 256 + wr * 64 + fr;
        if (u.pn < 64) {
            bf16_t* base; int ldc, colt;
            if (u.pn < 40) { base = pa; ldc = NA; colt = u.pn * 256; } else { base = pb; ldc = NB; colt = (u.pn - 40) * 256; }
            const int col0 = colt + wc * 32 + 8 * fq;
#pragma unroll
            for (int ai = 0; ai < 2; ++ai)
#pragma unroll
                for (int m = 0; m < 4; ++m) { bf16_t* rowp = base + (size_t)(row0 + ai * 128 + m * 16) * ldc + col0;
#pragma unroll
                    for (int bj = 0; bj < 2; ++bj) { const f32x4 v0 = acc[ai][bj][m][0], v1 = acc[ai][bj][m][1];
                        u32x4 w; w[0] = pk2(v0[0], v0[1]); w[1] = pk2(v0[2], v0[3]); w[2] = pk2(v1[0], v1[1]); w[3] = pk2(v1[2], v1[3]);
                        *(u32x4*)(rowp + bj * 128) = w; } }
        } else if (wc < 2) {
#pragma unroll
            for (int ai = 0; ai < 2; ++ai)
#pragma unroll
                for (int m = 0; m < 4; ++m) { float* rowp = gates + (size_t)(row0 + ai * 128 + m * 16) * 64 + wc * 32 + 8 * fq;
                    *(f32x4*)rowp = acc[ai][0][m][0]; *(f32x4*)(rowp + 4) = acc[ai][0][m][1]; }
        }
    }
};
struct Epi2 {
    static constexpr bool PERM = false, AFTER_DRAIN = false;
    const float* xp; const float* xs; float* y; float* rowss;
    DI void operator()(const f32x4 (&acc)[2][2][4][2], const pg8::Unit& u, int wr, int wc, int fr, int fq) const {
        const int row0 = u.pm * 256 + wr * 64 + fr, col0 = u.pn * 256 + wc * 32 + 4 * fq;
#pragma unroll
        for (int ai = 0; ai < 2; ++ai)
#pragma unroll
            for (int m = 0; m < 4; ++m) { const int row = row0 + ai * 128 + m * 16;
                const float* xr = (row < NPR ? xp + (size_t)row * DM : xs + (size_t)(row - NPR) * DM) + col0; float* yr = y + (size_t)row * DM + col0; float ssq = 0.f;
#pragma unroll
                for (int bj = 0; bj < 2; ++bj)
#pragma unroll
                    for (int n = 0; n < 2; ++n) { const f32x4 v = acc[ai][bj][m][n] + *(const f32x4*)(xr + bj * 128 + n * 16); *(f32x4*)(yr + bj * 128 + n * 16) = v;
                        ssq += v[0] * v[0] + v[1] * v[1] + v[2] * v[2] + v[3] * v[3]; }
                ssq += __shfl_xor(ssq, 16); ssq += __shfl_xor(ssq, 32);
                if (fq == 0) atomicAdd(rowss + row, ssq); }
    }
};

template <class F> DI void emit_frags(int tid, unsigned char* dst, int MT, int KS, F elem, int nthr = 512) {
    for (int idx = tid; idx < MT * KS * 64; idx += nthr) {
        const int f = idx >> 6, l = idx & 63, mt = f / KS, ks = f - mt * KS, r = l & 31, h = l >> 5;
        const int row = mt * 32 + r, cb = (ks >> 1) * 32 + (ks & 1) * 16 + 4 * h;
        const bf16x8 o = pack8(elem(row, cb), elem(row, cb + 1), elem(row, cb + 2), elem(row, cb + 3), elem(row, cb + 8), elem(row, cb + 9), elem(row, cb + 10), elem(row, cb + 11));
        *(bf16x8*)(dst + (size_t)idx * 16) = o;
    }
}

struct PreG { u32x4 raw[11]; f32x4 w0[4], w1[4]; float gbv, gav; };
DI void gdn_issue(const Params& p, int cgi, int hd, int tid, PreG& pre) {
    const int row0 = cgi * 64; const bool sample = cgi >= 256; const bool first = sample || ((cgi & 127) == 0);
    const bf16_t* pa = (const bf16_t*)(p.ws + OFF_PA); const float* gates = (const float*)((unsigned char*)p.out + DO_GATES);
    if (tid < 384) {
        const int which = tid >> 7, cgp = (tid >> 3) & 15, trun = tid & 7;
        const int cc0 = which * 2048 + hd * 128 + cgp * 8;
#pragma unroll
        for (int j = 0; j < 4; ++j) { pre.w0[j] = *(const f32x4*)(p.conv_w + j * 6144 + cc0); pre.w1[j] = *(const f32x4*)(p.conv_w + j * 6144 + cc0 + 4); }
#pragma unroll
        for (int i = 0; i < 11; ++i) { const int tt = trun * 8 - 3 + i;
            if (tt >= 0 || !first) pre.raw[i] = *(const u32x4*)(pa + (size_t)(row0 + tt) * NA + cc0);
            else if (sample) { const float* cp = p.cache + ((size_t)(cgi - 256) * 3 + (3 + tt)) * 6144 + cc0; const f32x4 a = *(const f32x4*)cp, b = *(const f32x4*)(cp + 4);
                pre.raw[i][0] = pk2(a[0], a[1]); pre.raw[i][1] = pk2(a[2], a[3]); pre.raw[i][2] = pk2(b[0], b[1]); pre.raw[i][3] = pk2(b[2], b[3]); }
            else { pre.raw[i][0] = 0u; pre.raw[i][1] = 0u; pre.raw[i][2] = 0u; pre.raw[i][3] = 0u; } }
    }
    if (tid >= 384 && tid < 448) { pre.gbv = gates[(size_t)(row0 + tid - 384) * 64 + hd]; pre.gav = gates[(size_t)(row0 + tid - 384) * 64 + 16 + hd]; }
}
DI void prep_gdn(const Params& p, unsigned char* smem, int cgi, int hd, PreG& pre, int ncgi, int nhd, bool has_next) {
    int tid_ = threadIdx.x; asm volatile("" : "+v"(tid_));
    const int tid = tid_, lane = tid & 63, wid = tid >> 6, r = lane & 31, h = lane >> 5;
    float* qf = (float*)smem; float* kf = qf + 64 * 132; float* vf = kf + 64 * 132; float* am = vf + 64 * 132; float* qk = am + 64 * 68; float* tm = qk + 64 * 68; float* sc = tm + 64 * 68;
    float* Gs = sc; float* betas = sc + 64; float* eGs = sc + 128; float* decs = sc + 192;
    const int row0 = cgi * 64; const bool sample = cgi >= 256; const bool first = sample || ((cgi & 127) == 0);
    const bf16_t* pa = (const bf16_t*)(p.ws + OFF_PA); const float* gates = (const float*)((unsigned char*)p.out + DO_GATES);
    unsigned char* blob = p.ws + OFF_PREPG + (size_t)gidx(cgi, hd) * BLOB;
    if (tid < 384) {
        const int which = tid >> 7, cgp = (tid >> 3) & 15, trun = tid & 7;
        float* dstm = which == 0 ? qf : which == 1 ? kf : vf;
#pragma unroll
        for (int o = 0; o < 8; ++o) { f32x4 y0, y1;
#pragma unroll
            for (int c = 0; c < 8; ++c) { float acc = 0.f;
#pragma unroll
                for (int j = 0; j < 4; ++j) { const unsigned wd = pre.raw[o + j][c >> 1]; const float xv = (c & 1) ? __uint_as_float(wd & 0xffff0000u) : __uint_as_float(wd << 16);
                    acc += xv * (c < 4 ? pre.w0[j][c & 3] : pre.w1[j][c & 3]); }
                if (c < 4) y0[c & 3] = silu_f(acc); else y1[c & 3] = silu_f(acc); }
            *(f32x4*)(dstm + (trun * 8 + o) * 132 + cgp * 8) = y0; *(f32x4*)(dstm + (trun * 8 + o) * 132 + cgp * 8 + 4) = y1; }
    }
    const float gbv = pre.gbv, gav = pre.gav;
    if (has_next) gdn_issue(p, ncgi, nhd, tid, pre);
    for (int idx = tid; idx < 64 * 68; idx += 512) tm[idx] = 0.f;
    if (tid >= 384 && tid < 448) { const int tg = tid - 384;
        const float beta = 1.f / (1.f + expf(-gbv));
        const float g = -expf(p.a_log[hd]) * softplus_f(gav + p.dt_bias[hd]);
        float G = g;
#pragma unroll
        for (int o = 1; o < 64; o <<= 1) { const float t2 = __shfl_up(G, o); if (lane >= o) G += t2; }
        const float GL = __shfl(G, 63);
        Gs[tg] = G; betas[tg] = beta; eGs[tg] = expf(G); decs[tg] = expf(GL - G);
        if (tg == 63) ((float*)((unsigned char*)p.out + DO_EGL))[cgi * 16 + hd] = expf(G);
    }
    __syncthreads();
    {
        const int t = tid >> 3, part = tid & 7; float* qp = qf + t * 132 + part * 16; float* kp = kf + t * 132 + part * 16;
        f32x4 qv[4], kv[4]; float sq = 0.f, sk = 0.f;
#pragma unroll
        for (int i = 0; i < 4; ++i) { qv[i] = *(const f32x4*)(qp + 4 * i); kv[i] = *(const f32x4*)(kp + 4 * i);
            sq += qv[i][0] * qv[i][0] + qv[i][1] * qv[i][1] + qv[i][2] * qv[i][2] + qv[i][3] * qv[i][3]; sk += kv[i][0] * kv[i][0] + kv[i][1] * kv[i][1] + kv[i][2] * kv[i][2] + kv[i][3] * kv[i][3]; }
        qk[tid] = sq; qk[512 + tid] = sk;
        __syncthreads();
        const f32x4 a0 = *(const f32x4*)(qk + t * 8), a1 = *(const f32x4*)(qk + t * 8 + 4), b0 = *(const f32x4*)(qk + 512 + t * 8), b1 = *(const f32x4*)(qk + 512 + t * 8 + 4);
        const float s1 = rsqrtf(a0[0] + a0[1] + a0[2] + a0[3] + a1[0] + a1[1] + a1[2] + a1[3] + 1e-6f) * 0.08838834764831845f;
        const float s2 = rsqrtf(b0[0] + b0[1] + b0[2] + b0[3] + b1[0] + b1[1] + b1[2] + b1[3] + 1e-6f);
#pragma unroll
        for (int i = 0; i < 4; ++i) { *(f32x4*)(qp + 4 * i) = qv[i] * s1; *(f32x4*)(kp + 4 * i) = kv[i] * s2; }
    }
    __syncthreads();
    { const int mat = wid >> 2, ti = (wid >> 1) & 1, tj = wid & 1; float* dstm = mat ? qk : am;
      if (ti == 0 && tj == 1) {
#pragma unroll
          for (int i = 0; i < 16; ++i) dstm[crow(i, h) * 68 + 32 + r] = 0.f;
      } else {
          const float* A = mat ? qf : kf; f32x16 acc;
#pragma unroll
          for (int i = 0; i < 16; ++i) acc[i] = 0.f;
#pragma unroll
          for (int ks = 0; ks < 8; ++ks) acc = MFMA32(ld8f(A + (ti * 32 + r) * 132 + ks * 16 + h * 8), ld8f(kf + (tj * 32 + r) * 132 + ks * 16 + h * 8), acc);
#pragma unroll
          for (int i = 0; i < 16; ++i) { const int t = ti * 32 + crow(i, h), s = tj * 32 + r;
              const bool keep = mat ? (s <= t) : (s < t); const float d = keep ? __expf(Gs[t] - Gs[s]) : 0.f;
              dstm[t * 68 + s] = mat ? acc[i] * d : betas[t] * acc[i] * d; }
      } }
    __syncthreads();
    if (tid >= 64) {
        emit_frags(tid - 64, blob + 32768, 2, 4, [&](int row, int col) { return qk[row * 68 + col]; }, 448);
        emit_frags(tid - 64, blob + 16384, 2, 8, [&](int row, int col) { return eGs[row] * qf[row * 132 + col]; }, 448);
        emit_frags(tid - 64, blob + 40960, 4, 4, [&](int row, int col) { return kf[col * 132 + row] * decs[col]; }, 448);
    }
    if (tid < 64) {
        const int b0 = (tid >> 4) * 16, col = tid & 15; float a[120], x[16];
#pragma unroll
        for (int i = 1; i < 16; ++i)
#pragma unroll
            for (int s2 = 0; s2 < i; ++s2) a[i * (i - 1) / 2 + s2] = am[(b0 + i) * 68 + b0 + s2];
#pragma unroll
        for (int i = 0; i < 16; ++i) { float v = (i == col) ? 1.f : 0.f;
#pragma unroll
            for (int s2 = 0; s2 < i; ++s2) v -= a[i * (i - 1) / 2 + s2] * x[s2];
            x[i] = v; tm[(b0 + i) * 68 + b0 + col] = v; }
        asm volatile("s_waitcnt lgkmcnt(0)" ::: "memory");
        const int r16 = r & 15;
#pragma unroll
        for (int B = 0; B < 2; ++B) {
            const int c0 = 32 * B; f32x16 mm, tt;
#pragma unroll
            for (int i = 0; i < 16; ++i) { mm[i] = 0.f; tt[i] = 0.f; }
            float bv[8];
#pragma unroll
            for (int j = 0; j < 8; ++j) bv[j] = tm[(c0 + 8 * h + j) * 68 + c0 + r16];
            mm = MFMA32(ld8f(am + (c0 + 16 + r16) * 68 + c0 + 8 * h), pack8(bv[0], bv[1], bv[2], bv[3], bv[4], bv[5], bv[6], bv[7]), mm);
            const float* tp = tm + (c0 + 16 + r16) * 68 + c0 + 16 + 4 * h; const f32x4 lo = *(const f32x4*)tp, hi = *(const f32x4*)(tp + 8);
            tt = MFMA32(pack8(lo[0], lo[1], lo[2], lo[3], hi[0], hi[1], hi[2], hi[3]), pack_step(mm, 0), tt);
#pragma unroll
            for (int i = 0; i < 8; ++i) if (r < 16) tm[(c0 + 16 + crow(i, h)) * 68 + c0 + r] = -tt[i];
        }
        asm volatile("s_waitcnt lgkmcnt(0)" ::: "memory");
    }
    if (wid == 0) {
        f32x16 m1;
#pragma unroll
        for (int i = 0; i < 16; ++i) m1[i] = 0.f;
#pragma unroll
        for (int ks = 0; ks < 2; ++ks) { float bv[8];
#pragma unroll
            for (int j = 0; j < 8; ++j) bv[j] = tm[(ks * 16 + 8 * h + j) * 68 + r];
            m1 = MFMA32(ld8f(am + (32 + r) * 68 + ks * 16 + 8 * h), pack8(bv[0], bv[1], bv[2], bv[3], bv[4], bv[5], bv[6], bv[7]), m1); }
        f32x16 t21;
#pragma unroll
        for (int i = 0; i < 16; ++i) t21[i] = 0.f;
#pragma unroll
        for (int s2 = 0; s2 < 2; ++s2) { const float* tp = tm + (32 + r) * 68 + 32 + 16 * s2 + 4 * h; const f32x4 lo = *(const f32x4*)tp, hi = *(const f32x4*)(tp + 8);
            t21 = MFMA32(pack8(lo[0], lo[1], lo[2], lo[3], hi[0], hi[1], hi[2], hi[3]), pack_step(m1, s2), t21); }
#pragma unroll
        for (int i = 0; i < 16; ++i) tm[(32 + crow(i, h)) * 68 + r] = -t21[i];
    }
    __syncthreads();
    { const int nt = wid & 3, mat = wid >> 2; const float* src = mat ? vf : kf;
      f32x16 acc0, acc1;
#pragma unroll
      for (int i = 0; i < 16; ++i) { acc0[i] = 0.f; acc1[i] = 0.f; }
#pragma unroll
      for (int ks = 0; ks < 4; ++ks) { float bv[8];
#pragma unroll
          for (int j = 0; j < 8; ++j) { const int s = ks * 16 + 8 * h + j; bv[j] = src[s * 132 + nt * 32 + r] * (mat ? betas[s] : betas[s] * eGs[s]); }
          const bf16x8 b = pack8(bv[0], bv[1], bv[2], bv[3], bv[4], bv[5], bv[6], bv[7]);
          const bf16x8 t0 = ld8f(tm + r * 68 + ks * 16 + 8 * h), t1 = ld8f(tm + (32 + r) * 68 + ks * 16 + 8 * h);
          if (mat) { acc0 = MFMA32(t0, b, acc0); acc1 = MFMA32(t1, b, acc1); }
          else { acc0 = MFMA32(b, t0, acc0); acc1 = MFMA32(b, t1, acc1); } }
      if (mat) {
          unsigned char* d0 = blob + 57344 + ((size_t)((0 * 4 + nt) * 64 + lane)) * 32; unsigned char* d1 = blob + 57344 + ((size_t)((1 * 4 + nt) * 64 + lane)) * 32;
          *(bf16x8*)d0 = pack_step(acc0, 0); *(bf16x8*)(d0 + 16) = pack_step(acc0, 1);
          *(bf16x8*)d1 = pack_step(acc1, 0); *(bf16x8*)(d1 + 16) = pack_step(acc1, 1);
      } else {
#pragma unroll
          for (int i = 0; i < 16; ++i) { acc0[i] = -acc0[i]; acc1[i] = -acc1[i]; }
#pragma unroll
          for (int s2 = 0; s2 < 2; ++s2) {
              *(bf16x8*)(blob + ((size_t)((0 * 8 + 2 * nt + s2) * 64 + lane)) * 16) = pack_step(acc0, s2);
              *(bf16x8*)(blob + ((size_t)((1 * 8 + 2 * nt + s2) * 64 + lane)) * 16) = pack_step(acc1, s2); }
      } }
    __syncthreads();
}

struct PreM { u32x4 qr[2], kr[2], vr[4]; float mi, mf; };
DI void ml_issue(const Params& p, int cgi, int hd, int tid, PreM& pre) {
    const int row0 = cgi * 64; const bf16_t* pa = (const bf16_t*)(p.ws + OFF_PA); const float* gates = (const float*)((unsigned char*)p.out + DO_GATES);
#pragma unroll
    for (int it = 0; it < 2; ++it) { const int idx = tid + 512 * it, t = idx >> 4, cgp = idx & 15;
        pre.qr[it] = *(const u32x4*)(pa + (size_t)(row0 + t) * NA + 6144 + hd * 128 + cgp * 8); pre.kr[it] = *(const u32x4*)(pa + (size_t)(row0 + t) * NA + 7168 + hd * 128 + cgp * 8); }
#pragma unroll
    for (int it = 0; it < 4; ++it) { const int idx = tid + 512 * it, t = idx >> 5, cgp = idx & 31; pre.vr[it] = *(const u32x4*)(pa + (size_t)(row0 + t) * NA + 8192 + hd * 256 + cgp * 8); }
    if (tid < 64) { pre.mi = gates[(size_t)(row0 + tid) * 64 + 32 + hd]; pre.mf = gates[(size_t)(row0 + tid) * 64 + 40 + hd]; }
}
DI void prep_ml(const Params& p, unsigned char* smem, int cgi, int hd, PreM& pre, int ncgi, int nhd, bool has_next) {
    int tid_ = threadIdx.x; asm volatile("" : "+v"(tid_));
    const int tid = tid_, lane = tid & 63, wid = tid >> 6, r = lane & 31, h = lane >> 5;
    float* qf = (float*)smem; float* kf = qf + 64 * 132; bf16_t* vb = (bf16_t*)(smem + 67584); float* pm = (float*)(smem + 101376); float* sc = (float*)(smem + 153600);
    float* as_ = sc; float* pms = sc + 64; float* wend = sc + 128;
    const int row0 = cgi * 64; const bf16_t* pa = (const bf16_t*)(p.ws + OFF_PA); const float* gates = (const float*)((unsigned char*)p.out + DO_GATES);
    unsigned char* blob = (unsigned char*)p.out + DO_PREPM + (size_t)midx(cgi, hd) * BLOB;
#pragma unroll
    for (int it = 0; it < 2; ++it) { const int idx = tid + 512 * it, t = idx >> 4, cgp = idx & 15;
        const u32x4 qr = pre.qr[it], kr = pre.kr[it];
        f32x4 a, b, c2, d; const float ks = 0.08838834764831845f;
        a[0] = __uint_as_float(qr[0] << 16); a[1] = __uint_as_float(qr[0] & 0xffff0000u); a[2] = __uint_as_float(qr[1] << 16); a[3] = __uint_as_float(qr[1] & 0xffff0000u);
        b[0] = __uint_as_float(qr[2] << 16); b[1] = __uint_as_float(qr[2] & 0xffff0000u); b[2] = __uint_as_float(qr[3] << 16); b[3] = __uint_as_float(qr[3] & 0xffff0000u);
        c2[0] = ks * __uint_as_float(kr[0] << 16); c2[1] = ks * __uint_as_float(kr[0] & 0xffff0000u); c2[2] = ks * __uint_as_float(kr[1] << 16); c2[3] = ks * __uint_as_float(kr[1] & 0xffff0000u);
        d[0] = ks * __uint_as_float(kr[2] << 16); d[1] = ks * __uint_as_float(kr[2] & 0xffff0000u); d[2] = ks * __uint_as_float(kr[3] << 16); d[3] = ks * __uint_as_float(kr[3] & 0xffff0000u);
        *(f32x4*)(qf + t * 132 + cgp * 8) = a; *(f32x4*)(qf + t * 132 + cgp * 8 + 4) = b; *(f32x4*)(kf + t * 132 + cgp * 8) = c2; *(f32x4*)(kf + t * 132 + cgp * 8 + 4) = d; }
#pragma unroll
    for (int it = 0; it < 4; ++it) { const int idx = tid + 512 * it, t = idx >> 5, cgp = idx & 31;
        *(u32x4*)(vb + t * 264 + cgp * 8) = pre.vr[it]; }
    const float mi = pre.mi, mf = pre.mf;
    if (has_next) ml_issue(p, ncgi, nhd, tid, pre);
    if (tid < 64) {
        const float logi = mi + p.b_i[hd]; const float logf = -softplus_f(-(mf + p.b_f[hd]));
        float b = logf;
#pragma unroll
        for (int o = 1; o < 64; o <<= 1) { const float t2 = __shfl_up(b, o); if (lane >= o) b += t2; }
        const float a = logi - b; float px = a;
#pragma unroll
        for (int o = 1; o < 64; o <<= 1) { const float t2 = __shfl_up(px, o); if (lane >= o) px = fmaxf(px, t2); }
        const float p63 = __shfl(px, 63);
        as_[tid] = a; pms[tid] = px; wend[tid] = expf(a - p63);
        ((float*)((unsigned char*)p.out + DO_MB))[(size_t)(row0 + tid) * 8 + hd] = b; ((float*)((unsigned char*)p.out + DO_MDMAX))[(size_t)(row0 + tid) * 8 + hd] = b + px;
    }
    __syncthreads();
    if (wid < 4) {
        const int ti = wid >> 1, tj = wid & 1;
        if (ti == 0 && tj == 1) {
#pragma unroll
            for (int i = 0; i < 16; ++i) pm[crow(i, h) * 68 + 32 + r] = 0.f;
        } else { f32x16 acc;
#pragma unroll
            for (int i = 0; i < 16; ++i) acc[i] = 0.f;
#pragma unroll
            for (int ks = 0; ks < 8; ++ks) acc = MFMA32(ld8f(qf + (ti * 32 + r) * 132 + ks * 16 + h * 8), ld8f(kf + (tj * 32 + r) * 132 + ks * 16 + h * 8), acc);
#pragma unroll
            for (int i = 0; i < 16; ++i) { const int t = ti * 32 + crow(i, h), s = tj * 32 + r; pm[t * 68 + s] = (s <= t) ? acc[i] * __expf(as_[s] - pms[t]) : 0.f; }
        }
    } else if (tid < 256 + 128) { const int k = tid - 256; float a = 0.f;
        for (int s = 0; s < 64; ++s) a += wend[s] * kf[s * 132 + k];
        ((float*)((unsigned char*)p.out + DO_KN))[((size_t)cgi * 8 + hd) * 128 + k] = a; }
    emit_frags(tid, blob, 2, 8, [&](int row, int col) { return qf[row * 132 + col]; });
    emit_frags(tid, blob + 24576, 4, 4, [&](int row, int col) { return kf[col * 132 + row] * wend[col]; });
    for (int idx = tid; idx < 8 * 4 * 64; idx += 512) { const int f = idx >> 6, l = idx & 63, nt = f >> 2, ks = f & 3, c = l & 31, hh = l >> 5;
        const int sb = (ks >> 1) * 32 + (ks & 1) * 16 + 4 * hh; bf16x8 o;
#pragma unroll
        for (int j = 0; j < 8; ++j) o[j] = (short)vb[(sb + 8 * (j >> 2) + (j & 3)) * 264 + nt * 32 + c];
        *(bf16x8*)(blob + 40960 + (size_t)idx * 16) = o; }
    __syncthreads();
    if (tid < 64) { float a = 0.f; for (int s = 0; s < 64; ++s) a += pm[tid * 68 + s]; ((float*)((unsigned char*)p.out + DO_MRS))[(size_t)(row0 + tid) * 8 + hd] = a; }
    emit_frags(tid, blob + 16384, 2, 4, [&](int row, int col) { return pm[row * 68 + col]; });
    __syncthreads();
}

DI void lds_copy_kb(LAS unsigned char* lbuf, const unsigned char* g, int nkb, int wid, int lane) {
    for (int kb = wid; kb < nkb; kb += 8)
        __builtin_amdgcn_global_load_lds((const unsigned*)(g + (size_t)kb * 1024 + lane * 16), (LAS unsigned*)(lbuf + kb * 1024), 16, 0, 0);
}
#define WAIT_ALL_VM() asm volatile("s_waitcnt vmcnt(0)" ::: "memory")
template <int NP> DI void ldp_gdn(u32x4 (&R)[NP], const unsigned char* g, int lw, int lane) {
    const unsigned lo = (unsigned)lane * 16u;
#pragma unroll
    for (int j = 0; j < NP; ++j) { const unsigned char* gj = g + (size_t)((lw * NP + j) * 1024); R[j] = *(const u32x4*)(gj + lo); } }
template <int NP> DI void ldp_ml(u32x4 (&R)[NP], const unsigned char* g, int half, int lw, int lane) {
    const unsigned lo = (unsigned)lane * 16u;
#pragma unroll
    for (int j = 0; j < NP; ++j) { const int kb = lw * NP + j; const unsigned char* gj = g + (size_t)((kb < 40 ? 0 : half * 16384) + kb * 1024); R[j] = *(const u32x4*)(gj + lo); } }
template <int NP> DI void stp(const u32x4 (&R)[NP], LAS unsigned char* l, int lw, int lane) {
#pragma unroll
    for (int j = 0; j < NP; ++j) *(LAS u32x4*)(l + ((lw * NP + j) * 64 + lane) * 16) = R[j]; }

DI void scan_gdn(const Params& p, unsigned char* smem, int seq, int hd) {
    int tid_ = threadIdx.x; asm volatile("" : "+v"(tid_));
    const int tid = tid_, lane = tid & 63, wid = __builtin_amdgcn_readfirstlane(tid >> 6), r = lane & 31, h = lane >> 5, w = wid;
    const int nch = seq < 2 ? 128 : 1, cg0 = seq < 2 ? seq * 128 : 256 + (seq - 2);
    LAS unsigned char* lds = (LAS unsigned char*)smem;
    const unsigned char* blob0 = p.ws + OFF_PREPG + (size_t)gidx(cg0, hd) * BLOB;
    const float* egl = (const float*)((unsigned char*)p.out + DO_EGL);
    const int sbase = (4 * h * 128 + 32 * (w & 3) + r) * 4;
    __syncthreads();
    if (seq >= 2) { lds_copy_kb(lds + BLOB, (const unsigned char*)(p.sg + ((size_t)(seq - 2) * 16 + hd) * 16384), 64, wid, lane); WAIT_ALL_VM(); }
    __syncthreads();
    if (w < 4) {
        f32x16 S[4];
        if (seq >= 2) {
#pragma unroll
            for (int kt = 0; kt < 4; ++kt)
#pragma unroll
                for (int i = 0; i < 16; ++i) S[kt][i] = *(const LAS float*)(lds + BLOB + sbase + (32 * kt + (i & 3) + 8 * (i >> 2)) * 512);
        } else {
#pragma unroll
            for (int kt = 0; kt < 4; ++kt)
#pragma unroll
                for (int i = 0; i < 16; ++i) S[kt][i] = 0.f;
        }
        float eg_next = egl[cg0 * 16 + hd];
        __syncthreads();
        __syncthreads();
        __builtin_amdgcn_s_setprio(3);
        for (int c = 0; c < nch; ++c) {
            const int cur = c & 1; const float eg = eg_next;
            if (c + 1 < nch) eg_next = egl[(cg0 + c + 1) * 16 + hd];
            const LAS unsigned char* buf = lds + cur * BLOB;
            f32x16 U[2], O[2];
#pragma unroll
            for (int mt = 0; mt < 2; ++mt) {
                const LAS bf16x8* up = (const LAS bf16x8*)(buf + 57344 + ((mt * 4 + w) * 64 + lane) * 32);
                const bf16x8 u0 = up[0], u1 = up[1];
#pragma unroll
                for (int i = 0; i < 8; ++i) { U[mt][i] = bf2f((bf16_t)u0[i]); U[mt][8 + i] = bf2f((bf16_t)u1[i]); O[mt][i] = 0.f; O[mt][8 + i] = 0.f; }
            }
#define FRG(off) (*(const LAS bf16x8*)(buf + (off) + lane * 16))
            bf16x8 fcur[6], fnxt[6];
            fcur[0] = FRG(0); fcur[1] = FRG(16384); fcur[2] = FRG(8192); fcur[3] = FRG(24576);
#pragma unroll
            for (int ks = 0; ks < 8; ++ks) {
                if (ks < 7) { fnxt[0] = FRG((ks + 1) * 1024); fnxt[1] = FRG(16384 + (ks + 1) * 1024); fnxt[2] = FRG(8192 + (ks + 1) * 1024); fnxt[3] = FRG(24576 + (ks + 1) * 1024); }
                else { fnxt[0] = FRG(32768); fnxt[1] = FRG(32768 + 4096); fnxt[2] = FRG(40960); fnxt[3] = FRG(40960 + 4096); fnxt[4] = FRG(40960 + 8192); fnxt[5] = FRG(40960 + 12288); }
                const bf16x8 sf = pack_step(S[ks >> 1], ks & 1);
                U[0] = MFMA32(fcur[0], sf, U[0]); O[0] = MFMA32(fcur[1], sf, O[0]); U[1] = MFMA32(fcur[2], sf, U[1]); O[1] = MFMA32(fcur[3], sf, O[1]);
                __builtin_amdgcn_sched_barrier(0);
#pragma unroll
                for (int i = 0; i < 6; ++i) fcur[i] = fnxt[i];
            }
#pragma unroll
            for (int kt = 0; kt < 4; ++kt)
#pragma unroll
                for (int i = 0; i < 16; ++i) S[kt][i] *= eg;
#pragma unroll
            for (int ks = 0; ks < 4; ++ks) {
                if (ks < 3) { fnxt[0] = FRG(32768 + (ks + 1) * 1024); fnxt[1] = FRG(32768 + 4096 + (ks + 1) * 1024);
#pragma unroll
                    for (int kt = 0; kt < 4; ++kt) fnxt[2 + kt] = FRG(40960 + kt * 4096 + (ks + 1) * 1024); }
                const bf16x8 uf = pack_step(U[ks >> 1], ks & 1);
                O[0] = MFMA32(fcur[0], uf, O[0]); O[1] = MFMA32(fcur[1], uf, O[1]);
#pragma unroll
                for (int kt = 0; kt < 4; ++kt) S[kt] = MFMA32(fcur[2 + kt], uf, S[kt]);
                __builtin_amdgcn_sched_barrier(0);
#pragma unroll
                for (int i = 0; i < 6; ++i) fcur[i] = fnxt[i];
            }
#undef FRG
            unsigned long long ob = (unsigned long long)(oraw_blk(p, gidx(cg0 + c, hd)) + (4 * h) * 128 + 32 * w + r);
            asm volatile("" : "+v"(ob));
#pragma unroll
            for (int mt = 0; mt < 2; ++mt)
#pragma unroll
                for (int i = 0; i < 16; ++i) *(GAS bf16_t*)(ob + (size_t)(32 * mt + (i & 3) + 8 * (i >> 2)) * 256) = f2bf(O[mt][i]);
            __syncthreads();
        }
        __builtin_amdgcn_s_setprio(0);
#pragma unroll
        for (int kt = 0; kt < 4; ++kt)
#pragma unroll
            for (int i = 0; i < 16; ++i) *(LAS float*)(lds + sbase + (32 * kt + (i & 3) + 8 * (i >> 2)) * 512) = S[kt][i];
    } else {
        const int lw = w - 4;
        if (nch == 1) {
            u32x4 Ra[18];
            ldp_gdn(Ra, blob0, lw, lane);
            __syncthreads();
            stp(Ra, lds, lw, lane);
            __syncthreads();
            __syncthreads();
        } else {
        u32x4 Ra[18], Rb[18];
        const int last = nch - 1;
#define GBLOB(cc) (blob0 + (size_t)((cc) < last ? (cc) : last) * BLOB)
        ldp_gdn(Ra, blob0, lw, lane);
        __syncthreads();
        stp(Ra, lds, lw, lane);
        ldp_gdn(Rb, GBLOB(1), lw, lane);
        ldp_gdn(Ra, GBLOB(2), lw, lane);
        __syncthreads();
        for (int c = 0; c < nch; c += 2) {
            stp(Rb, lds + BLOB, lw, lane);
            ldp_gdn(Rb, GBLOB(c + 3), lw, lane);
            __syncthreads();
            if (c + 1 < nch) {
                stp(Ra, lds, lw, lane);
                ldp_gdn(Ra, GBLOB(c + 4), lw, lane);
                __syncthreads();
            }
        }
#undef GBLOB
            }
    }
    {   float* dst = p.out + (seq < 2 ? O_GDN_P + ((size_t)seq * 16 + hd) * 16384 : O_GDN_S + ((size_t)(seq - 2) * 16 + hd) * 16384);
        __syncthreads();
        for (int i = tid; i < 4096; i += 512) *(f32x4*)(dst + i * 4) = *(const LAS f32x4*)(lds + i * 16);
        __syncthreads();
    }
}

DI void scan_ml(const Params& p, unsigned char* smem, int seq, int hd, int half) {
    int tid_ = threadIdx.x; asm volatile("" : "+v"(tid_));
    const int tid = tid_, lane = tid & 63, wid = __builtin_amdgcn_readfirstlane(tid >> 6), r = lane & 31, h = lane >> 5, w = wid;
    const int nch = seq < 2 ? 128 : 1, cg0 = seq < 2 ? seq * 128 : 256 + (seq - 2);
    LAS unsigned char* lds = (LAS unsigned char*)smem; float* scr = (float*)(smem + 147456) + wid * 128;
    const unsigned char* blob0 = (const unsigned char*)p.out + DO_PREPM + (size_t)midx(cg0, hd) * BLOB;
    bf16_t* num = (bf16_t*)((unsigned char*)p.out + DO_NUM);
    const float* mbp = (const float*)((unsigned char*)p.out + DO_MB); const float* mdp = (const float*)((unsigned char*)p.out + DO_MDMAX); const float* knp = (const float*)((unsigned char*)p.out + DO_KN);
    float* ncs = (float*)((unsigned char*)p.out + DO_NCS); float* mcs = (float*)((unsigned char*)p.out + DO_MCS);
    const bool nwave = (w == 4) && (half == 0);
    float m = 0.f;
    if (seq >= 2) m = p.sm[(seq - 2) * 8 + hd];
    const int sbase = (4 * h * 128 + 32 * (w & 3) + r) * 4;
    __syncthreads();
    if (seq >= 2) {
        const unsigned char* C0 = (const unsigned char*)(p.sc + ((size_t)(seq - 2) * 8 + hd) * 32768) + half * 512;
        for (int kb = wid; kb < 64; kb += 8)
            __builtin_amdgcn_global_load_lds((const unsigned*)(C0 + (size_t)(2 * kb + (lane >> 5)) * 1024 + (lane & 31) * 16), (LAS unsigned*)(lds + BLOB + kb * 1024), 16, 0, 0);
        WAIT_ALL_VM();
    }
    __syncthreads();
    float bt_n = mbp[((size_t)cg0 * 64 + lane) * 8 + hd], dm_n = mdp[((size_t)cg0 * 64 + lane) * 8 + hd];
    if (w < 4) {
        f32x16 C[4];
        if (seq >= 2) {
#pragma unroll
            for (int kt = 0; kt < 4; ++kt)
#pragma unroll
                for (int i = 0; i < 16; ++i) C[kt][i] = *(const LAS float*)(lds + BLOB + sbase + (32 * kt + (i & 3) + 8 * (i >> 2)) * 512);
        } else {
#pragma unroll
            for (int kt = 0; kt < 4; ++kt)
#pragma unroll
                for (int i = 0; i < 16; ++i) C[kt][i] = 0.f;
        }
        __syncthreads();
        __syncthreads();
        __builtin_amdgcn_s_setprio(3);
        for (int c = 0; c < nch; ++c) {
            const int cur = c & 1; const int cgi = cg0 + c;
            const float bt = bt_n, dm = dm_n;
            if (c + 1 < nch) { bt_n = mbp[((size_t)(cgi + 1) * 64 + lane) * 8 + hd]; dm_n = mdp[((size_t)(cgi + 1) * 64 + lane) * 8 + hd]; }
            const float bL = __shfl(bt, 63), E = __shfl(dm, 63);
            const float inter = bt + m, mtv = fmaxf(inter, dm), wq = __expf(inter - mtv), rr = __expf(dm - mtv);
            const float m_new = __shfl(mtv, 63), wC = __expf(bL + m - m_new), sE = __expf(E - m_new);
            const LAS unsigned char* buf = lds + cur * BLOB;
            scr[lane] = wq; scr[64 + lane] = rr;
#define FRG(off) (*(const LAS bf16x8*)(buf + (off) + lane * 16))
            bf16x8 Vf[4];
#pragma unroll
            for (int ks = 0; ks < 4; ++ks) Vf[ks] = FRG(40960 + (w * 4 + ks) * 1024);
            unsigned long long ob = (unsigned long long)(num + (size_t)midx(cgi, hd) * 16384 + (4 * h) * 256 + half * 128 + 32 * w + r);
            asm volatile("" : "+v"(ob));
            const float* scrh = scr + 4 * h;
            f32x16 QC[2], PV[2];
#pragma unroll
            for (int i = 0; i < 16; ++i) { QC[0][i] = 0.f; QC[1][i] = 0.f; PV[0][i] = 0.f; PV[1][i] = 0.f; }
            bf16x8 fcur[4], fnxt[4];
            fcur[0] = FRG(0); fcur[1] = FRG(8192); fcur[2] = FRG(16384); fcur[3] = FRG(16384 + 4096);
#pragma unroll
            for (int ks = 0; ks < 8; ++ks) {
                if (ks < 7) { fnxt[0] = FRG((ks + 1) * 1024); fnxt[1] = FRG(8192 + (ks + 1) * 1024); if (ks < 3) { fnxt[2] = FRG(16384 + (ks + 1) * 1024); fnxt[3] = FRG(16384 + 4096 + (ks + 1) * 1024); } }
                else { fnxt[0] = FRG(24576); fnxt[1] = FRG(24576 + 4096); fnxt[2] = FRG(24576 + 8192); fnxt[3] = FRG(24576 + 12288); }
                const bf16x8 cf = pack_step(C[ks >> 1], ks & 1);
                QC[0] = MFMA32(fcur[0], cf, QC[0]); QC[1] = MFMA32(fcur[1], cf, QC[1]);
                if (ks < 4) { PV[0] = MFMA32(fcur[2], Vf[ks], PV[0]); PV[1] = MFMA32(fcur[3], Vf[ks], PV[1]); }
                __builtin_amdgcn_sched_barrier(0);
#pragma unroll
                for (int i = 0; i < 4; ++i) fcur[i] = fnxt[i];
            }
#pragma unroll
            for (int kt = 0; kt < 4; ++kt)
#pragma unroll
                for (int i = 0; i < 16; ++i) C[kt][i] *= wC;
#pragma unroll
            for (int ks = 0; ks < 4; ++ks) { float f[8];
#pragma unroll
                for (int j = 0; j < 8; ++j) f[j] = sE * bf2f((bf16_t)Vf[ks][j]);
                Vf[ks] = pack8(f[0], f[1], f[2], f[3], f[4], f[5], f[6], f[7]); }
#pragma unroll
            for (int ks = 0; ks < 4; ++ks) {
                if (ks < 3) {
#pragma unroll
                    for (int kt = 0; kt < 4; ++kt) fnxt[kt] = FRG(24576 + kt * 4096 + (ks + 1) * 1024); }
#pragma unroll
                for (int kt = 0; kt < 4; ++kt) C[kt] = MFMA32(fcur[kt], Vf[ks], C[kt]);
                __builtin_amdgcn_sched_barrier(0);
#pragma unroll
                for (int i = 0; i < 4; ++i) fcur[i] = fnxt[i];
            }
#undef FRG
#pragma unroll
            for (int mt = 0; mt < 2; ++mt)
#pragma unroll
                for (int i = 0; i < 16; ++i) { const int t0 = 32 * mt + (i & 3) + 8 * (i >> 2);
                    *(GAS bf16_t*)(ob + (size_t)t0 * 512) = f2bf(scrh[t0] * QC[mt][i] + scrh[64 + t0] * PV[mt][i]); }
            m = m_new;
            __syncthreads();
        }
        __builtin_amdgcn_s_setprio(0);
#pragma unroll
        for (int kt = 0; kt < 4; ++kt)
#pragma unroll
            for (int i = 0; i < 16; ++i) *(LAS float*)(lds + sbase + (32 * kt + (i & 3) + 8 * (i >> 2)) * 512) = C[kt][i];
    } else {
        const int lw = w - 4;
        float n0 = 0.f, n1 = 0.f, k0_n = 0.f, k1_n = 0.f;
        if (nwave) { if (seq >= 2) { n0 = p.sn[((size_t)(seq - 2) * 8 + hd) * 128 + lane]; n1 = p.sn[((size_t)(seq - 2) * 8 + hd) * 128 + 64 + lane]; }
            k0_n = knp[((size_t)cg0 * 8 + hd) * 128 + lane]; k1_n = knp[((size_t)cg0 * 8 + hd) * 128 + 64 + lane]; }
        auto nstep = [&](int c) {
            const int cgi = cg0 + c;
            const float bt = bt_n, dm = dm_n, k0 = k0_n, k1 = k1_n;
            if (c + 1 < nch) { bt_n = mbp[((size_t)(cgi + 1) * 64 + lane) * 8 + hd]; dm_n = mdp[((size_t)(cgi + 1) * 64 + lane) * 8 + hd];
                k0_n = knp[((size_t)(cgi + 1) * 8 + hd) * 128 + lane]; k1_n = knp[((size_t)(cgi + 1) * 8 + hd) * 128 + 64 + lane]; }
            const float bL = __shfl(bt, 63), E = __shfl(dm, 63);
            const float mtv = fmaxf(bt + m, dm);
            const float m_new = __shfl(mtv, 63), wC = __expf(bL + m - m_new), sE = __expf(E - m_new);
            ncs[((size_t)cgi * 8 + hd) * 128 + lane] = n0; ncs[((size_t)cgi * 8 + hd) * 128 + 64 + lane] = n1;
            if (lane == 0) mcs[cgi * 8 + hd] = m;
            n0 = wC * n0 + sE * k0; n1 = wC * n1 + sE * k1;
            m = m_new;
        };
        if (nch == 1) {
            u32x4 Ra[14];
            ldp_ml(Ra, blob0, half, lw, lane);
            __syncthreads();
            stp(Ra, lds, lw, lane);
            __syncthreads();
            if (nwave) nstep(0);
            __syncthreads();
        } else {
        u32x4 Ra[14], Rb[14];
        const int last = nch - 1;
#define MBLOB(cc) (blob0 + (size_t)((cc) < last ? (cc) : last) * BLOB)
        ldp_ml(Ra, blob0, half, lw, lane);
        __syncthreads();
        stp(Ra, lds, lw, lane);
        ldp_ml(Rb, MBLOB(1), half, lw, lane);
        ldp_ml(Ra, MBLOB(2), half, lw, lane);
        __syncthreads();
        for (int c = 0; c < nch; c += 2) {
            stp(Rb, lds + BLOB, lw, lane);
            ldp_ml(Rb, MBLOB(c + 3), half, lw, lane);
            if (nwave) nstep(c);
            __syncthreads();
            if (c + 1 < nch) {
                stp(Ra, lds, lw, lane);
                ldp_ml(Ra, MBLOB(c + 4), half, lw, lane);
                if (nwave) nstep(c + 1);
                __syncthreads();
            }
        }
        }
#undef MBLOB
        if (nwave) {
            float* dn = p.out + (seq < 2 ? O_N_P + ((size_t)seq * 8 + hd) * 128 : O_N_S + ((size_t)(seq - 2) * 8 + hd) * 128);
            dn[lane] = n0; dn[64 + lane] = n1;
            if (lane == 0) p.out[(seq < 2 ? O_M_P + seq * 8 + hd : O_M_S + (seq - 2) * 8 + hd)] = m;
        }
    }
    {   float* dst = p.out + (seq < 2 ? O_C_P + ((size_t)seq * 8 + hd) * 32768 : O_C_S + ((size_t)(seq - 2) * 8 + hd) * 32768) + half * 128;
        __syncthreads();
        for (int i = tid; i < 4096; i += 512) *(f32x4*)(dst + (i >> 5) * 256 + (i & 31) * 4) = *(const LAS f32x4*)(lds + i * 16);
        __syncthreads();
    }
}

struct TableOrder {
    const unsigned* tab; int n, G, c; bool remap;
    DI bool next(int i, pg8::Unit& u) const {
        const long L = (long)i * G + c; if (L >= n) return false;
        int w = (int)L;
        if (remap) { const int q = n / 8, r = n % 8, xcd = w % 8, off = w / 8; w = (xcd < r ? xcd * (q + 1) : r * (q + 1) + (xcd - r) * q) + off; }
        const unsigned v = tab[w]; u.pm = (int)(v >> 8); u.pn = (int)(v & 255u); return true;
    }
    DI void a_ready(const pg8::Unit&) const {}
    DI void done(const pg8::Unit&) const {}
};
DI void gemm1_units(const Params& p, unsigned char* smem, const unsigned* tab, int n, int G, int c, bool remap) {
    pg8::Gemm g; g.A = (const bf16_t*)(p.ws + OFF_H); g.Bt = (const bf16_t*)(p.ws + OFF_BT1); g.M = NTOK; g.N = N1; g.K = DM;
    TableOrder S; S.tab = tab; S.n = n; S.G = G; S.c = c; S.remap = remap;
    Epi1 E; E.pa = (bf16_t*)(p.ws + OFF_PA); E.pb = (bf16_t*)(p.ws + OFF_PB); E.gates = (float*)((unsigned char*)p.out + DO_GATES);
    pg8::gemm_phase<Epi1, TableOrder, false>((LAS unsigned char*)smem, g, S, E, nullptr);
    __syncthreads();
}
DI void phase1(const Params& p, unsigned char* smem) {
    gemm1_units(p, smem, (const unsigned*)((const unsigned char*)p.out + DO_TABK), NKEPT, (int)gridDim.x, (int)blockIdx.x, true);
}
DI void phase3(const Params& p, unsigned char* smem) {
    const int b = blockIdx.x;
    if (b < 32) { if (p.mode3 & 1) scan_gdn(p, smem, b >> 4, b & 15); }
    else if (b < 64) { if (p.mode3 & 1) { const int i = b - 32; scan_ml(p, smem, i >> 4, (i >> 1) & 7, i & 1); } }
    else {
        if (p.mode3 & 2) for (int it = b - 64; it < 1024; it += gridDim.x - 64) {
            if (it < 512) scan_gdn(p, smem, 2 + (it >> 4), it & 15);
            else { const int i = it - 512; scan_ml(p, smem, 2 + (i >> 4), (i >> 1) & 7, i & 1); }
            __syncthreads();
        }
        __syncthreads();
        if (p.mode3 & 4) gemm1_units(p, smem, (const unsigned*)((const unsigned char*)p.out + DO_TABD), NDEF, (int)gridDim.x - 64, b - 64, false);
    }
}

DI void unpk8(const u32x4 v, float (&f)[8]) {
#pragma unroll
    for (int i = 0; i < 4; ++i) { f[2 * i] = __uint_as_float(v[i] << 16); f[2 * i + 1] = __uint_as_float(v[i] & 0xffff0000u); } }
DI void phase4(const Params& p, unsigned char* smem) {
    int tid_ = threadIdx.x; asm volatile("" : "+v"(tid_));
    const int tid = tid_, lane = tid & 63, wid = tid >> 6;
    const int gw = blockIdx.x * 8 + wid, nw = gridDim.x * 8;
    const bf16_t* num = (const bf16_t*)((const unsigned char*)p.out + DO_NUM);
    const bf16_t* pa = (const bf16_t*)(p.ws + OFF_PA); const bf16_t* pb = (const bf16_t*)(p.ws + OFF_PB);
    const float* mbp = (const float*)((unsigned char*)p.out + DO_MB); const float* mdp = (const float*)((unsigned char*)p.out + DO_MDMAX); const float* mrs = (const float*)((unsigned char*)p.out + DO_MRS);
    const float* ncs = (const float*)((unsigned char*)p.out + DO_NCS); const float* mcs = (const float*)((unsigned char*)p.out + DO_MCS);
    bf16_t* mixed = (bf16_t*)(p.ws + OFF_MIXED);
    const int hm = lane >> 3, sub = lane & 7;
    transpose_tiles(p, smem, tid, true);
    for (int row = gw; row < NTOK; row += nw) {
        const int cgi = row >> 6;
        const bf16_t* orow = oraw_blk(p, gidx(cgi, lane >> 2)) + (row & 63) * 128 + (lane & 3) * 32;
        u32x4 ov[4], zv[4];
#pragma unroll
        for (int i = 0; i < 4; ++i) { ov[i] = *(const u32x4*)(orow + i * 8); zv[i] = *(const u32x4*)(pb + (size_t)row * NB + lane * 32 + i * 8); }
        {
            float ss = 0.f;
#pragma unroll
            for (int i = 0; i < 4; ++i) { float f[8]; unpk8(ov[i], f);
#pragma unroll
                for (int j = 0; j < 8; ++j) ss += f[j] * f[j]; }
            ss += __shfl_xor(ss, 1); ss += __shfl_xor(ss, 2);
            const float rs = rsqrtf(ss * (1.f / 128.f) + 1e-6f);
#pragma unroll
            for (int i = 0; i < 4; ++i) { float f[8], z[8]; unpk8(ov[i], f); unpk8(zv[i], z);
                const f32x4 g0 = *(const f32x4*)(p.gdn_nw + (lane & 3) * 32 + i * 8), g1 = *(const f32x4*)(p.gdn_nw + (lane & 3) * 32 + i * 8 + 4);
                u32x4 o; o[0] = pk2(f[0] * rs * g0[0] * silu_f(z[0]), f[1] * rs * g0[1] * silu_f(z[1])); o[1] = pk2(f[2] * rs * g0[2] * silu_f(z[2]), f[3] * rs * g0[3] * silu_f(z[3]));
                o[2] = pk2(f[4] * rs * g1[0] * silu_f(z[4]), f[5] * rs * g1[1] * silu_f(z[5])); o[3] = pk2(f[6] * rs * g1[2] * silu_f(z[6]), f[7] * rs * g1[3] * silu_f(z[7]));
                *(u32x4*)(mixed + (size_t)row * DM + lane * 32 + i * 8) = o; }
        }
        __builtin_amdgcn_sched_barrier(0);
        u32x4 nv[4], mov[4], mzv[4], qv[2]; f32x4 nn[4];
#pragma unroll
        for (int i = 0; i < 4; ++i) { nv[i] = *(const u32x4*)(num + (size_t)midx(cgi, hm) * 16384 + (row & 63) * 256 + sub * 32 + i * 8); mov[i] = *(const u32x4*)(pb + (size_t)row * NB + 2048 + lane * 32 + i * 8);
            mzv[i] = *(const u32x4*)(pb + (size_t)row * NB + 4096 + lane * 32 + i * 8); nn[i] = *(const f32x4*)(ncs + ((size_t)cgi * 8 + hm) * 128 + sub * 16 + i * 4); }
        qv[0] = *(const u32x4*)(pa + (size_t)row * NA + 6144 + hm * 128 + sub * 16); qv[1] = *(const u32x4*)(pa + (size_t)row * NA + 6144 + hm * 128 + sub * 16 + 8);
        const float mc = mcs[cgi * 8 + hm], bt = mbp[(size_t)row * 8 + hm], dm = mdp[(size_t)row * 8 + hm], rsm = mrs[(size_t)row * 8 + hm];
        {
            float qf8[8], qn = 0.f;
            unpk8(qv[0], qf8); qn += qf8[0] * nn[0][0] + qf8[1] * nn[0][1] + qf8[2] * nn[0][2] + qf8[3] * nn[0][3] + qf8[4] * nn[1][0] + qf8[5] * nn[1][1] + qf8[6] * nn[1][2] + qf8[7] * nn[1][3];
            unpk8(qv[1], qf8); qn += qf8[0] * nn[2][0] + qf8[1] * nn[2][1] + qf8[2] * nn[2][2] + qf8[3] * nn[2][3] + qf8[4] * nn[3][0] + qf8[5] * nn[3][1] + qf8[6] * nn[3][2] + qf8[7] * nn[3][3];
            qn += __shfl_xor(qn, 1); qn += __shfl_xor(qn, 2); qn += __shfl_xor(qn, 4);
            const float inter = bt + mc, mtv = fmaxf(inter, dm), wq = __expf(inter - mtv), rr = __expf(dm - mtv);
            const float den = wq * qn + rr * rsm; const float inv = 1.f / fmaxf(fabsf(den), __expf(-mtv));
            float ss = 0.f;
#pragma unroll
            for (int i = 0; i < 4; ++i) { float f[8]; unpk8(nv[i], f);
#pragma unroll
                for (int j = 0; j < 8; ++j) { const float hv = f[j] * inv; ss += hv * hv; } }
            ss += __shfl_xor(ss, 1); ss += __shfl_xor(ss, 2); ss += __shfl_xor(ss, 4);
            const float rs = rsqrtf(ss * (1.f / 256.f) + 1e-6f) * inv;
#pragma unroll
            for (int i = 0; i < 4; ++i) { float f[8], a[8], z[8]; unpk8(nv[i], f); unpk8(mov[i], a); unpk8(mzv[i], z);
                const f32x4 g0 = *(const f32x4*)(p.ml_nw + sub * 32 + i * 8), g1 = *(const f32x4*)(p.ml_nw + sub * 32 + i * 8 + 4);
                u32x4 o; o[0] = pk2(f[0] * rs * g0[0] * sigm_f(a[0]) * silu_f(z[0]), f[1] * rs * g0[1] * sigm_f(a[1]) * silu_f(z[1]));
                o[1] = pk2(f[2] * rs * g0[2] * sigm_f(a[2]) * silu_f(z[2]), f[3] * rs * g0[3] * sigm_f(a[3]) * silu_f(z[3]));
                o[2] = pk2(f[4] * rs * g1[0] * sigm_f(a[4]) * silu_f(z[4]), f[5] * rs * g1[1] * sigm_f(a[5]) * silu_f(z[5]));
                o[3] = pk2(f[6] * rs * g1[2] * sigm_f(a[6]) * silu_f(z[6]), f[7] * rs * g1[3] * sigm_f(a[7]) * silu_f(z[7]));
                *(u32x4*)(mixed + (size_t)row * DM + 2048 + lane * 32 + i * 8) = o; }
        }
    }
    for (int i = blockIdx.x * 512 + tid; i < 34 * 3 * 6144; i += gridDim.x * 512) {
        const int c = i % 6144, j = (i / 6144) % 3, s = i / (3 * 6144);
        const size_t row = s < 2 ? (size_t)s * 8192 + 8189 + j : (size_t)NPR + (size_t)(s - 2) * 64 + 61 + j;
        const float v = bf2f(pa[row * NA + c]);
        if (s < 2) p.out[O_CONV_P + ((size_t)s * 3 + j) * 6144 + c] = v; else p.out[O_CONV_S + ((size_t)(s - 2) * 3 + j) * 6144 + c] = v;
    }
}

DI void phase6(const Params& p) {
    int tid_ = threadIdx.x; asm volatile("" : "+v"(tid_));
    const int tid = tid_, lane = tid & 63, wid = tid >> 6;
    const int gw = blockIdx.x * 8 + wid, nw = gridDim.x * 8;
    const float* rowss = (const float*)(p.ws + OFF_ROWSS);
    for (int row = gw; row < NTOK; row += nw) {
        float* yr = p.out + (size_t)row * DM; const float rs = rsqrtf(rowss[row] * (1.f / DM) + 1e-6f);
#pragma unroll
        for (int i = 0; i < 16; ++i) { const f32x4 g = *(const f32x4*)(p.final_g + (lane + 64 * i) * 4); f32x4 v = *(const f32x4*)(yr + (lane + 64 * i) * 4);
            v[0] *= rs * g[0]; v[1] *= rs * g[1]; v[2] *= rs * g[2]; v[3] *= rs * g[3]; *(f32x4*)(yr + (lane + 64 * i) * 4) = v; }
    }
}

DI void phase2(const Params& p, unsigned char* smem) {
    const int G = gridDim.x; int it = blockIdx.x;
    {   PreG pre;
        if (it < 4608) gdn_issue(p, it >> 4, it & 15, threadIdx.x, pre);
#pragma unroll 1
        for (; it < 4608; it += G) { const int nit = it + G; prep_gdn(p, smem, it >> 4, it & 15, pre, nit >> 4, nit & 15, nit < 4608); }
    }
    {   PreM pre;
        if (it < 6912) ml_issue(p, (it - 4608) >> 3, (it - 4608) & 7, threadIdx.x, pre);
#pragma unroll 1
        for (; it < 6912; it += G) { const int nit = it + G; prep_ml(p, smem, (it - 4608) >> 3, (it - 4608) & 7, pre, (nit - 4608) >> 3, (nit - 4608) & 7, nit < 6912); }
    }
}
DI void phase5(const Params& p, unsigned char* smem) {
    pg8::Gemm g; g.A = (const bf16_t*)(p.ws + OFF_MIXED); g.Bt = (const bf16_t*)(p.ws + OFF_BT2); g.M = NTOK; g.N = DM; g.K = DM;
    pg8::StaticOrder S; S.init(g.M, g.N, (int)gridDim.x, (int)blockIdx.x);
    Epi2 E; E.xp = p.xp; E.xs = p.xs; E.y = p.out; E.rowss = (float*)(p.ws + OFF_ROWSS);
    pg8::gemm_phase<Epi2, pg8::StaticOrder, false>((LAS unsigned char*)smem, g, S, E, nullptr);
    __syncthreads();
}

__global__ __launch_bounds__(512, 2) void mega(Params p) {
    extern __shared__ __attribute__((aligned(16))) unsigned char smem[];
    cg::grid_group grid = cg::this_grid();
#ifndef PHMASK
#define PHMASK 127
#endif
#ifndef DBLMASK
#define DBLMASK 0
#endif
#define PHASE(i, call) if constexpr ((PHMASK >> (i)) & 1) { if (p.ph_lo <= (i) && (i) <= p.ph_hi) { call; if ((i) < p.ph_hi) grid.sync(); } }
    PHASE(0, phase0(p, smem))
    PHASE(1, phase1(p, smem))
    PHASE(2, phase2(p, smem))
    PHASE(3, phase3(p, smem))
    PHASE(4, phase4(p, smem))
    PHASE(5, phase5(p, smem))
    PHASE(6, phase6(p))
}

#ifndef N_LAUNCH_SPLIT
#define N_LAUNCH_SPLIT 1
#endif
extern "C" void kernel_launch(void* const* d_in, const int* in_sizes, int n_in, void* d_out, int out_size, void* d_ws, size_t ws_size, hipStream_t stream) {
    static int grid = 0;
    if (grid == 0) {
        if (ws_size < WS_END || n_in != 18) { fprintf(stderr, "kernel_launch: workspace %zu < %zu or n_in %d != 18\n", ws_size, (size_t)WS_END, n_in); grid = -1; return; }
        int dev = 0, cus = 0, per_cu = 0;
        (void)hipGetDevice(&dev); (void)hipDeviceGetAttribute(&cus, hipDeviceAttributeMultiprocessorCount, dev);
        (void)hipFuncSetAttribute((const void*)mega, hipFuncAttributeMaxDynamicSharedMemorySize, LDS_BYTES);
        (void)hipOccupancyMaxActiveBlocksPerMultiprocessor(&per_cu, (const void*)mega, 512, LDS_BYTES);
        if (per_cu < 1) { fprintf(stderr, "kernel_launch: occupancy query says %d blocks/CU\n", per_cu); per_cu = 1; }
        (void)hipGetLastError();
        grid = cus;
    }
    if (grid < 0) return;
    Params p{};
    p.xp = (const float*)d_in[0]; p.xs = (const float*)d_in[1]; p.cache = (const float*)d_in[2]; p.sg = (const float*)d_in[3]; p.sc = (const float*)d_in[4];
    p.sn = (const float*)d_in[5]; p.sm = (const float*)d_in[6]; p.norm_g = (const float*)d_in[7]; p.w_in = (const float*)d_in[8]; p.conv_w = (const float*)d_in[9];
    p.a_log = (const float*)d_in[10]; p.dt_bias = (const float*)d_in[11]; p.gdn_nw = (const float*)d_in[12]; p.b_i = (const float*)d_in[13]; p.b_f = (const float*)d_in[14];
    p.ml_nw = (const float*)d_in[15]; p.w_out = (const float*)d_in[16]; p.final_g = (const float*)d_in[17];
    p.out = (float*)d_out; p.ws = (unsigned char*)d_ws; p.mode3 = 7;
#if N_LAUNCH_SPLIT == 1
    p.ph_lo = 0; p.ph_hi = 6;
    void* args[] = {&p};
    hipError_t e = hipLaunchCooperativeKernel((const void*)mega, dim3(grid), dim3(512), args, LDS_BYTES, stream);
    if (e != hipSuccess) fprintf(stderr, "cooperative launch failed: %s (grid %d)\n", hipGetErrorString(e), grid);
#else
    for (int ph = 0; ph <= 6; ++ph) { p.ph_lo = ph; p.ph_hi = ph; const int reps = 1 + ((DBLMASK >> ph) & 1);
        for (int rep = 0; rep < reps; ++rep) hipLaunchKernelGGL(mega, dim3(grid), dim3(512), LDS_BYTES, stream, p);
        if (ph == 3 && (DBLMASK >> 7)) { p.mode3 = (DBLMASK >> 7) & 7; hipLaunchKernelGGL(mega, dim3(grid), dim3(512), LDS_BYTES, stream, p); p.mode3 = 7; } }
#endif
}
```

```cpp
#include <hip/hip_runtime.h>
#include <hip/hip_cooperative_groups.h>
#include <cstdio>
namespace cg = cooperative_groups;
#define N_LAUNCH_SPLIT 1
#define DBLMASK 0
namespace pg8 {
#define PG8_LAS __attribute__((address_space(3)))
typedef unsigned short bf16_t;
typedef short bf16x8 __attribute__((ext_vector_type(8)));
typedef float f32x4 __attribute__((ext_vector_type(4)));
typedef unsigned u32x4 __attribute__((ext_vector_type(4)));
constexpr int BM = 256, BK = 64, HALF = 128, HTB = HALF * BK * 2  , STAGE_BYTES = 8 * HTB, NXCD = 8, WGM = 8;

__host__ __device__ __forceinline__ int lds_byte(int r, int c) { const int st = (r >> 4) * 2 + (c >> 5), rr = r & 15, cc = c & 31, ob = rr * 64 + cc * 2; return st * 1024 + (ob ^ (((ob >> 9) & 1) << 5)); }
__host__ __device__ __forceinline__ void stage_rc(int b, int& R, int& C) { const int st = b / 1024, sb = b % 1024, swz = sb ^ (((sb >> 9) & 1) << 5); R = (st >> 1) * 16 + swz / 64; C = (st & 1) * 32 + (swz % 64) / 2; }
__host__ __device__ __forceinline__ int perm32(int rho) { const int n = rho >> 4, i = rho & 15; return 8 * (i >> 2) + 4 * n + (i & 3); }

struct Unit { int pm, pn; };
struct Gemm { const bf16_t* A; const bf16_t* Bt; int M, N, K; };

struct StaticOrder {
    int nM, nN, nwg, G, c;
    __host__ __device__ void init(int M, int N, int G_, int c_) { nM = M / BM; nN = N / BM; nwg = nM * nN; G = G_; c = c_; }
    __host__ __device__ bool next(int i, Unit& u) const {
        const long L = (long)i * G + c; if (L >= nwg) return false;
        int wgid = (int)L; { const int q = nwg / NXCD, r = nwg % NXCD, xcd = wgid % NXCD, off = wgid / NXCD; wgid = (xcd < r ? xcd * (q + 1) : r * (q + 1) + (xcd - r) * q) + off; }
        const int nig = WGM * nN, gid = wgid / nig, fm = gid * WGM, gsz = (nM - fm) < WGM ? (nM - fm) : WGM;
        u.pm = fm + ((wgid % nig) % gsz); u.pn = (wgid % nig) / gsz; return true;
    }
    __device__ __forceinline__ void a_ready(const Unit&) const {}
    __device__ __forceinline__ void done(const Unit&) const {}
};
template <class Epi, class Sched, bool STAMP = false>
__device__ __forceinline__ void gemm_phase(PG8_LAS unsigned char* lds, const Gemm g, const Sched& S, const Epi& E, unsigned long long* stamps) {
    const int tid = threadIdx.x, wid = __builtin_amdgcn_readfirstlane(tid >> 6), lane = tid & 63, wr = wid >> 2, wc = wid & 3, fr = lane & 15, fq = lane >> 4;
    const int K = g.K, nt = K / BK;
    int ts_lo = 0, ts_hi = 0, nts = 0; const unsigned long long rt_entry = STAMP ? (unsigned long long)wall_clock64() : 0ull;
#define PG8_STAMP() do { if (STAMP && wid == 0 && nts < 64) { const unsigned long long _c = (unsigned long long)clock64(); \
        ts_lo = (lane == nts) ? (int)(unsigned)_c : ts_lo; ts_hi = (lane == nts) ? (int)(unsigned)(_c >> 32) : ts_hi; ++nts; } } while (0)
    PG8_STAMP();
    unsigned voffA[2], voffB[2];
#pragma unroll
    for (int i = 0; i < 2; ++i) { int R, C; stage_rc(tid * 16 + i * 8192, R, C); const int Rb = Epi::PERM ? ((R & ~31) + perm32(R & 31)) : R;
        voffA[i] = (unsigned)(R * K + C) * 2u; voffB[i] = (unsigned)(Rb * K + C) * 2u; }
    const size_t kstep = (size_t)(BK * 2);
    const size_t hstep = (size_t)HALF * K * 2;
    const size_t tstep = 2 * hstep;
    const unsigned ldsw = (unsigned)wid * 1024u;
    const int aoff = lds_byte(wr * 64 + fr, fq * 8), boff = lds_byte(wc * 32 + fr, fq * 8);
#define PG8_SA(b, h) (((b) * 2 + (h)) * HTB)
#define PG8_SB(b, h) ((4 + (b) * 2 + (h)) * HTB)
#define PG8_STAGE(bufoff, gbase, voff) do { _Pragma("unroll") for (int _i = 0; _i < 2; ++_i) \
        __builtin_amdgcn_global_load_lds((const unsigned*)((const char*)(gbase) + (voff)[_i]), (PG8_LAS unsigned*)(lds + (bufoff) + ldsw + _i * 8192), 16, 0, 0); } while (0)
#define PG8_LDA(dst, b, h) do { _Pragma("unroll") for (int m = 0; m < 4; ++m) _Pragma("unroll") for (int k = 0; k < 2; ++k) dst[m][k] = *(const PG8_LAS bf16x8*)(lds + PG8_SA(b, h) + aoff + m * 2048 + k * 1024); } while (0)
#define PG8_LDB(dst, b, h) do { _Pragma("unroll") for (int n = 0; n < 2; ++n) _Pragma("unroll") for (int k = 0; k < 2; ++k) dst[n][k] = *(const PG8_LAS bf16x8*)(lds + PG8_SB(b, h) + boff + n * 2048 + k * 1024); } while (0)
#define PG8_MMA(ai, bj, At, Bt) do { __builtin_amdgcn_s_setprio(1); _Pragma("unroll") for (int m = 0; m < 4; ++m) _Pragma("unroll") for (int n = 0; n < 2; ++n) _Pragma("unroll") for (int k = 0; k < 2; ++k) \
        acc[ai][bj][m][n] = __builtin_amdgcn_mfma_f32_16x16x32_bf16(Bt[n][k], At[m][k], acc[ai][bj][m][n], 0, 0, 0); __builtin_amdgcn_s_setprio(0); } while (0)
#define PG8_WAIT_V(n) asm volatile("s_waitcnt vmcnt(" #n ")" ::: "memory")
#define PG8_WAIT_L(n) asm volatile("s_waitcnt lgkmcnt(" #n ")" ::: "memory")
#define PG8_BAR __builtin_amdgcn_s_barrier()
#define PG8_SCHED __builtin_amdgcn_sched_barrier(0)
    Unit cur, nxt; int ui = 0;
    if (!S.next(0, cur)) return;
    f32x4 acc[2][2][4][2];
#pragma unroll
    for (int a = 0; a < 2; ++a)
#pragma unroll
        for (int b = 0; b < 2; ++b)
#pragma unroll
            for (int m = 0; m < 4; ++m)
#pragma unroll
                for (int n = 0; n < 2; ++n) acc[a][b][m][n] = (f32x4){0.f, 0.f, 0.f, 0.f};
    bf16x8 At[4][2], B0[2][2], B1[2][2];
    const char* cA = (const char*)g.A + (size_t)cur.pm * tstep; const char* cB = (const char*)g.Bt + (size_t)cur.pn * tstep;
    S.a_ready(cur);
    PG8_STAGE(PG8_SB(0, 0), cB, voffB); PG8_STAGE(PG8_SA(0, 0), cA, voffA); PG8_STAGE(PG8_SB(0, 1), cB + hstep, voffB); PG8_STAGE(PG8_SA(0, 1), cA + hstep, voffA);
    if (wr == 1) PG8_BAR;
    PG8_WAIT_V(4); PG8_BAR;
    PG8_STAGE(PG8_SB(1, 0), cB + kstep, voffB); PG8_STAGE(PG8_SA(1, 0), cA + kstep, voffA); PG8_STAGE(PG8_SB(1, 1), cB + hstep + kstep, voffB);
    PG8_WAIT_V(6); PG8_BAR;
    PG8_STAMP();
    for (;;) {
        const bool has_next = S.next(ui + 1, nxt);
        const char* nA = has_next ? (const char*)g.A + (size_t)nxt.pm * tstep : cA; const char* nB = has_next ? (const char*)g.Bt + (size_t)nxt.pn * tstep : cB;
        for (int t = 0; t < nt; t += 2) {
            const bool last = (t == nt - 2);
            const char* a1 = cA + (size_t)(t + 1) * kstep;
            const char* a2 = last ? nA : cA + (size_t)(t + 2) * kstep; const char* b2 = last ? nB : cB + (size_t)(t + 2) * kstep;
            const char* a3 = a2 + kstep; const char* b3 = b2 + kstep;
            if (last && has_next) S.a_ready(nxt);
            PG8_LDB(B0, 0, 0); PG8_SCHED; PG8_LDA(At, 0, 0); PG8_STAGE(PG8_SA(1, 1), a1 + hstep, voffA);
            PG8_WAIT_L(8); PG8_BAR; PG8_WAIT_L(0); PG8_MMA(0, 0, At, B0); PG8_BAR; PG8_SCHED;
            PG8_LDB(B1, 0, 1); PG8_STAGE(PG8_SB(0, 0), b2, voffB);
            PG8_BAR; PG8_WAIT_L(0); PG8_MMA(0, 1, At, B1); PG8_BAR;
            PG8_LDA(At, 0, 1); PG8_STAGE(PG8_SA(0, 0), a2, voffA);
            PG8_BAR; PG8_WAIT_L(0); PG8_MMA(1, 0, At, B0); PG8_BAR; PG8_SCHED;
            PG8_STAGE(PG8_SB(0, 1), b2 + hstep, voffB);
            PG8_WAIT_V(6); PG8_BAR; PG8_MMA(1, 1, At, B1); PG8_BAR;
            PG8_LDB(B0, 1, 0); PG8_SCHED; PG8_LDA(At, 1, 0); PG8_STAGE(PG8_SA(0, 1), a2 + hstep, voffA);
            PG8_WAIT_L(8); PG8_BAR; PG8_WAIT_L(0); PG8_MMA(0, 0, At, B0); PG8_BAR; PG8_SCHED;
            PG8_LDB(B1, 1, 1); PG8_STAGE(PG8_SB(1, 0), b3, voffB);
            PG8_BAR; PG8_WAIT_L(0); PG8_MMA(0, 1, At, B1); PG8_BAR;
            PG8_LDA(At, 1, 1); PG8_STAGE(PG8_SA(1, 0), a3, voffA);
            PG8_BAR; PG8_WAIT_L(0); PG8_MMA(1, 0, At, B0); PG8_BAR; PG8_SCHED;
            PG8_STAGE(PG8_SB(1, 1), b3 + hstep, voffB);
            PG8_WAIT_V(6); PG8_BAR; PG8_MMA(1, 1, At, B1); PG8_BAR;
        }
        PG8_STAMP();
        if constexpr (!Epi::AFTER_DRAIN) { E(acc, cur, wr, wc, fr, fq); S.done(cur); }
        PG8_STAMP();
        if (!has_next) break;
#pragma unroll
        for (int a = 0; a < 2; ++a)
#pragma unroll
            for (int b = 0; b < 2; ++b)
#pragma unroll
                for (int m = 0; m < 4; ++m)
#pragma unroll
                    for (int n = 0; n < 2; ++n) acc[a][b][m][n] = (f32x4){0.f, 0.f, 0.f, 0.f};
        cur = nxt; cA = nA; cB = nB; ++ui;
    }
    PG8_WAIT_V(0);
    if (wr == 0) PG8_BAR;
    PG8_BAR;
    if constexpr (Epi::AFTER_DRAIN) { E.fused(acc, cur, wr, wc, fr, fq, lds, wid, lane); S.done(cur); }
    PG8_STAMP();
    if (STAMP && wid == 0) { stamps[lane] = lane < nts ? (((unsigned long long)(unsigned)ts_hi << 32) | (unsigned)ts_lo) : 0ull;
        if (lane == 62) stamps[62] = rt_entry; if (lane == 63) stamps[63] = (unsigned long long)wall_clock64(); }
#undef PG8_STAMP
#undef PG8_SA
#undef PG8_SB
#undef PG8_STAGE
#undef PG8_LDA
#undef PG8_LDB
#undef PG8_MMA
#undef PG8_WAIT_V
#undef PG8_WAIT_L
#undef PG8_BAR
#undef PG8_SCHED
}
}
using pg8::bf16_t; using pg8::bf16x8; using pg8::f32x4; using pg8::u32x4;
typedef float f32x16 __attribute__((ext_vector_type(16)));
typedef __bf16 bf16x2_t __attribute__((ext_vector_type(2)));
typedef float f32x2_t __attribute__((ext_vector_type(2)));
#define DI __device__ __forceinline__
#define LAS __attribute__((address_space(3)))
#define GAS __attribute__((address_space(1)))
#define MFMA32(a, b, c) __builtin_amdgcn_mfma_f32_32x32x16_bf16((a), (b), (c), 0, 0, 0)

constexpr int DM = 4096, NTOK = 18432, NPR = 16384, NA = 10240, NB = 6144, N1 = 16640;
constexpr size_t BLOB = 73728;
constexpr size_t OFF_H = 0, OFF_PREPG = 29360128ull, OFF_BT1 = 285212672ull, OFF_MIXED = OFF_PREPG, OFF_BT2 = OFF_MIXED + 150994944ull,
    OFF_PA = OFF_BT1 + 136314880ull, OFF_PB = OFF_PA + (size_t)NTOK * NA * 2, OFF_ORAW0 = OFF_PB + (size_t)NTOK * NB * 2, OFF_ROWSS = OFF_ORAW0 + 9216ull * 4096, WS_END = OFF_ROWSS + 73728;
static_assert(OFF_PREPG + 4608ull * BLOB == OFF_BT1 + 10240ull * 8192, "overlay must end where the protected Bt1 rows start");
constexpr size_t DO_PREPM = 0, DO_NUM = 2304ull * BLOB, DO_ORAW1 = DO_NUM + (size_t)NTOK * 2048 * 2, DO_GATES = DO_ORAW1 + 9216ull * 4096, DO_EGL = DO_GATES + (size_t)NTOK * 64 * 4,
    DO_MB = DO_EGL + 18432, DO_MDMAX = DO_MB + 589824, DO_MRS = DO_MDMAX + 589824, DO_KN = DO_MRS + 589824, DO_NCS = DO_KN + 1179648, DO_MCS = DO_NCS + 1179648,
    DO_TABK = DO_MCS + 9216, DO_TABD = DO_TABK + 18944, DO_END = DO_TABD + 1536;
static_assert(DO_END <= 301989888ull, "d_out scratch must fit in the y region");
constexpr int NKEPT = 4344, NDEF = 336;
constexpr size_t O_Y = 0, O_CONV_P = 75497472ull, O_GDN_P = O_CONV_P + 36864, O_C_P = O_GDN_P + 524288, O_N_P = O_C_P + 524288, O_M_P = O_N_P + 2048,
    O_CONV_S = O_M_P + 16, O_GDN_S = O_CONV_S + 589824, O_C_S = O_GDN_S + 8388608, O_N_S = O_C_S + 8388608, O_M_S = O_N_S + 32768;
constexpr int LDS_BYTES = 155648;

struct Params {
    const float *xp, *xs, *cache, *sg, *sc, *sn, *sm, *norm_g, *w_in, *conv_w, *a_log, *dt_bias, *gdn_nw, *b_i, *b_f, *ml_nw, *w_out, *final_g;
    float* out; unsigned char* ws; int ph_lo, ph_hi, mode3, pad_;
};

DI int gidx(int cgi, int hd) { return cgi < 256 ? (((cgi >> 7) * 16 + hd) * 128 + (cgi & 127)) : (4096 + (cgi - 256) * 16 + hd); }
DI int midx(int cgi, int hd) { return cgi < 256 ? (((cgi >> 7) * 8 + hd) * 128 + (cgi & 127)) : (2048 + (cgi - 256) * 8 + hd); }
DI bf16_t* oraw_blk(const Params& p, int gi) { return gi < 2304 ? (bf16_t*)(p.ws + OFF_ORAW0) + (size_t)gi * 8192 : (bf16_t*)((unsigned char*)p.out + DO_ORAW1) + (size_t)(gi - 2304) * 8192; }
DI float bf2f(bf16_t b) { return __uint_as_float(((unsigned)b) << 16); }
DI unsigned pk2(float a, float b) { f32x2_t v = {a, b}; bf16x2_t r = __builtin_convertvector(v, bf16x2_t); return __builtin_bit_cast(unsigned, r); }
DI bf16_t f2bf(float a) { return (bf16_t)(pk2(a, 0.f) & 0xffffu); }
DI bf16x8 pack8(float a0, float a1, float a2, float a3, float a4, float a5, float a6, float a7) {
    u32x4 p; p[0] = pk2(a0, a1); p[1] = pk2(a2, a3); p[2] = pk2(a4, a5); p[3] = pk2(a6, a7); return __builtin_bit_cast(bf16x8, p); }
DI bf16x8 pack_step(const f32x16& x, int s) { return pack8(x[8 * s], x[8 * s + 1], x[8 * s + 2], x[8 * s + 3], x[8 * s + 4], x[8 * s + 5], x[8 * s + 6], x[8 * s + 7]); }
DI int crow(int reg, int h) { return (reg & 3) + 8 * (reg >> 2) + 4 * h; }
DI float wave_sum(float v) { for (int o = 32; o >= 1; o >>= 1) v += __shfl_xor(v, o); return v; }
DI bf16x8 ld8f(const float* p) { const f32x4 a = *(const f32x4*)p, b = *(const f32x4*)(p + 4); return pack8(a[0], a[1], a[2], a[3], b[0], b[1], b[2], b[3]); }
DI float silu_f(float y) { return y * __builtin_amdgcn_rcpf(1.f + __expf(-y)); }
DI float sigm_f(float y) { return __builtin_amdgcn_rcpf(1.f + __expf(-y)); }
DI float softplus_f(float x) { return fmaxf(x, 0.f) + log1pf(expf(-fabsf(x))); }

DI int emap1(int n) {
    if (n < 6144) return n;
    if (n < 10240) return 8224 + (n - 6144);
    if (n < 12288) return 6144 + (n - 10240);
    if (n < 16384) return 12320 + (n - 12288);
    if (n < 16416) return 8192 + (n - 16384);
    if (n < 16432) return n;
    return -1;
}
DI void transpose_tiles(const Params& p, unsigned char* smem, int tid, bool second) {
    float* tl = (float*)smem;
    bf16_t* dst = (bf16_t*)(p.ws + (second ? OFF_BT2 : OFF_BT1));
    const int NT = second ? 32 * 32 : (N1 / 128) * 32;
    const float* src = second ? p.w_out : p.w_in; const int ld = second ? 4096 : 16432;
    const int nn = tid & 127;
    for (int tt = blockIdx.x; tt < NT; tt += gridDim.x) {
        const int n0 = (tt >> 5) * 128, d0 = (tt & 31) * 128;
        const int e = second ? (n0 + nn) : emap1(n0 + nn);
        float v[32];
#pragma unroll
        for (int i = 0; i < 32; ++i) { const int dd = (tid >> 7) + 4 * i; v[i] = e >= 0 ? src[(size_t)(d0 + dd) * ld + e] : 0.f; }
#pragma unroll
        for (int i = 0; i < 32; ++i) { const int dd = (tid >> 7) + 4 * i; tl[dd * 129 + nn] = v[i]; }
        __syncthreads();
        const int ds = (tid & 15) * 8;
#pragma unroll
        for (int k = 0; k < 4; ++k) { const int nn2 = (tid >> 4) + 32 * k;
            const bf16x8 o = pack8(tl[(ds + 0) * 129 + nn2], tl[(ds + 1) * 129 + nn2], tl[(ds + 2) * 129 + nn2], tl[(ds + 3) * 129 + nn2], tl[(ds + 4) * 129 + nn2], tl[(ds + 5) * 129 + nn2], tl[(ds + 6) * 129 + nn2], tl[(ds + 7) * 129 + nn2]);
            *(bf16x8*)(dst + (size_t)(n0 + nn2) * DM + d0 + ds) = o; }
        __syncthreads();
    }
}
DI void phase0(const Params& p, unsigned char* smem) {
    int tid_ = threadIdx.x; asm volatile("" : "+v"(tid_));
    const int tid = tid_, lane = tid & 63, wid = tid >> 6;
    const int gw = blockIdx.x * 8 + wid, nw = gridDim.x * 8;
    bf16_t* hb = (bf16_t*)(p.ws + OFF_H);
    for (int row = gw; row < NTOK; row += nw) {
        const float* xr = row < NPR ? p.xp + (size_t)row * DM : p.xs + (size_t)(row - NPR) * DM;
        f32x4 v[16]; float ss = 0.f;
#pragma unroll
        for (int i = 0; i < 16; ++i) { v[i] = *(const f32x4*)(xr + (lane + 64 * i) * 4); ss += v[i][0] * v[i][0] + v[i][1] * v[i][1] + v[i][2] * v[i][2] + v[i][3] * v[i][3]; }
        ss = wave_sum(ss);
        const float rs = rsqrtf(ss * (1.f / DM) + 1e-6f);
#pragma unroll
        for (int i = 0; i < 16; ++i) { const f32x4 g = *(const f32x4*)(p.norm_g + (lane + 64 * i) * 4);
            uint2 o; o.x = pk2(v[i][0] * rs * g[0], v[i][1] * rs * g[1]); o.y = pk2(v[i][2] * rs * g[2], v[i][3] * rs * g[3]);
            *(uint2*)(hb + (size_t)row * DM + (lane + 64 * i) * 4) = o; }
    }
    float* rowss = (float*)(p.ws + OFF_ROWSS);
    for (int i = blockIdx.x * 512 + tid; i < NTOK; i += gridDim.x * 512) rowss[i] = 0.f;
    transpose_tiles(p, smem, tid, false);
    if (blockIdx.x == 0 && wid == 0) {
        unsigned* tk = (unsigned*)((unsigned char*)p.out + DO_TABK); unsigned* td = (unsigned*)((unsigned char*)p.out + DO_TABD);
        int nk = 0, nd = 0;
        for (int base = 0; base < 4680; base += 64) { const int wg = base + lane; const bool valid = wg < 4680;
            const int gid = wg / 520, rem = wg - gid * 520, pm = gid * 8 + (rem & 7), pn = rem >> 3;
            const bool def = valid && pn >= 40 && pn < 64 && pm < 14, keep = valid && !def;
            const unsigned long long mk = __ballot(keep), md = __ballot(def); const unsigned long long below = (1ull << lane) - 1ull;
            if (keep) tk[nk + __popcll(mk & below)] = (unsigned)(pm << 8 | pn);
            if (def) td[nd + __popcll(md & below)] = (unsigned)(pm << 8 | pn);
            nk += __popcll(mk); nd += __popcll(md); }
    }
}

struct Epi1 {
    static constexpr bool PERM = true, AFTER_DRAIN = false;
    bf16_t* pa; bf16_t* pb; float* gates;
    DI void operator()(const f32x4 (&acc)[2][2][4][2], const pg8::Unit& u, int wr, int wc, int fr, int fq) const {
        const int row0 = u.pm * 256 + wr * 64 + fr;
        if (u.pn < 64) {
            bf16_t* base; int ldc, colt;
            if (u.pn < 40) { base = pa; ldc = NA; colt = u.pn * 256; } else { base = pb; ldc = NB; colt = (u.pn - 40) * 256; }
            const int col0 = colt + wc * 32 + 8 * fq;
#pragma unroll
            for (int ai = 0; ai < 2; ++ai)
#pragma unroll
                for (int m = 0; m < 4; ++m) { bf16_t* rowp = base + (size_t)(row0 + ai * 128 + m * 16) * ldc + col0;
#pragma unroll
                    for (int bj = 0; bj < 2; ++bj) { const f32x4 v0 = acc[ai][bj][m][0], v1 = acc[ai][bj][m][1];
                        u32x4 w; w[0] = pk2(v0[0], v0[1]); w[1] = pk2(v0[2], v0[3]); w[2] = pk2(v1[0], v1[1]); w[3] = pk2(v1[2], v1[3]);
                        *(u32x4*)(rowp + bj * 128) = w; } }
        } else if (wc < 2) {
#pragma unroll
            for (int ai = 0; ai < 2; ++ai)
#pragma unroll
                for (int m = 0; m < 4; ++m) { float* rowp = gates + (size_t)(row0 + ai * 128 + m * 16) * 64 + wc * 32 + 8 * fq;
                    *(f32x4*)rowp = acc[ai][0][m][0]; *(f32x4*)(rowp + 4) = acc[ai][0][m][1]; }
        }
    }
};
struct Epi2 {
    static constexpr bool PERM = false, AFTER_DRAIN = false;
    const float* xp; const float* xs; float* y; float* rowss;
    DI void operator()(const f32x4 (&acc)[2][2][4][2], const pg8::Unit& u, int wr, int wc, int fr, int fq) const {
        const int row0 = u.pm * 256 + wr * 64 + fr, col0 = u.pn * 256 + wc * 32 + 4 * fq;
#pragma unroll
        for (int ai = 0; ai < 2; ++ai)
#pragma unroll
            for (int m = 0; m < 4; ++m) { const int row = row0 + ai * 128 + m * 16;
                const float* xr = (row < NPR ? xp + (size_t)row * DM : xs + (size_t)(row - NPR) * DM) + col0; float* yr = y + (size_t)row * DM + col0; float ssq = 0.f;
#pragma unroll
                for (int bj = 0; bj < 2; ++bj)
#pragma unroll
                    for (int n = 0; n < 2; ++n) { const f32x4 v = acc[ai][bj][m][n] + *(const f32x4*)(xr + bj * 128 + n * 16); *(f32x4*)(yr + bj * 128 + n * 16) = v;
                        ssq += v[0] * v[0] + v[1] * v[1] + v[2] * v[2] + v[3] * v[3]; }
                ssq += __shfl_xor(ssq, 16); ssq += __shfl_xor(ssq, 32);
                if (fq == 0) atomicAdd(rowss + row, ssq); }
    }
};

template <class F> DI void emit_frags(int tid, unsigned char* dst, int MT, int KS, F elem, int nthr = 512) {
    for (int idx = tid; idx < MT * KS * 64; idx += nthr) {
        const int f = idx >> 6, l = idx & 63, mt = f / KS, ks = f - mt * KS, r = l & 31, h = l >> 5;
        const int row = mt * 32 + r, cb = (ks >> 1) * 32 + (ks & 1) * 16 + 4 * h;
        const bf16x8 o = pack8(elem(row, cb), elem(row, cb + 1), elem(row, cb + 2), elem(row, cb + 3), elem(row, cb + 8), elem(row, cb + 9), elem(row, cb + 10), elem(row, cb + 11));
        *(bf16x8*)(dst + (size_t)idx * 16) = o;
    }
}

struct PreG { u32x4 raw[11]; f32x4 w0[4], w1[4]; float gbv, gav; };
DI void gdn_issue(const Params& p, int cgi, int hd, int tid, PreG& pre) {
    const int row0 = cgi * 64; const bool sample = cgi >= 256; const bool first = sample || ((cgi & 127) == 0);
    const bf16_t* pa = (const bf16_t*)(p.ws + OFF_PA); const float* gates = (const float*)((unsigned char*)p.out + DO_GATES);
    if (tid < 384) {
        const int which = tid >> 7, cgp = (tid >> 3) & 15, trun = tid & 7;
        const int cc0 = which * 2048 + hd * 128 + cgp * 8;
#pragma unroll
        for (int j = 0; j < 4; ++j) { pre.w0[j] = *(const f32x4*)(p.conv_w + j * 6144 + cc0); pre.w1[j] = *(const f32x4*)(p.conv_w + j * 6144 + cc0 + 4); }
#pragma unroll
        for (int i = 0; i < 11; ++i) { const int tt = trun * 8 - 3 + i;
            if (tt >= 0 || !first) pre.raw[i] = *(const u32x4*)(pa + (size_t)(row0 + tt) * NA + cc0);
            else if (sample) { const float* cp = p.cache + ((size_t)(cgi - 256) * 3 + (3 + tt)) * 6144 + cc0; const f32x4 a = *(const f32x4*)cp, b = *(const f32x4*)(cp + 4);
                pre.raw[i][0] = pk2(a[0], a[1]); pre.raw[i][1] = pk2(a[2], a[3]); pre.raw[i][2] = pk2(b[0], b[1]); pre.raw[i][3] = pk2(b[2], b[3]); }
            else { pre.raw[i][0] = 0u; pre.raw[i][1] = 0u; pre.raw[i][2] = 0u; pre.raw[i][3] = 0u; } }
    }
    if (tid >= 384 && tid < 448) { pre.gbv = gates[(size_t)(row0 + tid - 384) * 64 + hd]; pre.gav = gates[(size_t)(row0 + tid - 384) * 64 + 16 + hd]; }
}
DI void prep_gdn(const Params& p, unsigned char* smem, int cgi, int hd, PreG& pre, int ncgi, int nhd, bool has_next) {
    int tid_ = threadIdx.x; asm volatile("" : "+v"(tid_));
    const int tid = tid_, lane = tid & 63, wid = tid >> 6, r = lane & 31, h = lane >> 5;
    float* qf = (float*)smem; float* kf = qf + 64 * 132; float* vf = kf + 64 * 132; float* am = vf + 64 * 132; float* qk = am + 64 * 68; float* tm = qk + 64 * 68; float* sc = tm + 64 * 68;
    float* Gs = sc; float* betas = sc + 64; float* eGs = sc + 128; float* decs = sc + 192;
    const int row0 = cgi * 64; const bool sample = cgi >= 256; const bool first = sample || ((cgi & 127) == 0);
    const bf16_t* pa = (const bf16_t*)(p.ws + OFF_PA); const float* gates = (const float*)((unsigned char*)p.out + DO_GATES);
    unsigned char* blob = p.ws + OFF_PREPG + (size_t)gidx(cgi, hd) * BLOB;
    if (tid < 384) {
        const int which = tid >> 7, cgp = (tid >> 3) & 15, trun = tid & 7;
        float* dstm = which == 0 ? qf : which == 1 ? kf : vf;
#pragma unroll
        for (int o = 0; o < 8; ++o) { f32x4 y0, y1;
#pragma unroll
            for (int c = 0; c < 8; ++c) { float acc = 0.f;
#pragma unroll
                for (int j = 0; j < 4; ++j) { const unsigned wd = pre.raw[o + j][c >> 1]; const float xv = (c & 1) ? __uint_as_float(wd & 0xffff0000u) : __uint_as_float(wd << 16);
                    acc += xv * (c < 4 ? pre.w0[j][c & 3] : pre.w1[j][c & 3]); }
                if (c < 4) y0[c & 3] = silu_f(acc); else y1[c & 3] = silu_f(acc); }
            *(f32x4*)(dstm + (trun * 8 + o) * 132 + cgp * 8) = y0; *(f32x4*)(dstm + (trun * 8 + o) * 132 + cgp * 8 + 4) = y1; }
    }
    const float gbv = pre.gbv, gav = pre.gav;
    if (has_next) gdn_issue(p, ncgi, nhd, tid, pre);
    for (int idx = tid; idx < 64 * 68; idx += 512) tm[idx] = 0.f;
    if (tid >= 384 && tid < 448) { const int tg = tid - 384;
        const float beta = 1.f / (1.f + expf(-gbv));
        const float g = -expf(p.a_log[hd]) * softplus_f(gav + p.dt_bias[hd]);
        float G = g;
#pragma unroll
        for (int o = 1; o < 64; o <<= 1) { const float t2 = __shfl_up(G, o); if (lane >= o) G += t2; }
        const float GL = __shfl(G, 63);
        Gs[tg] = G; betas[tg] = beta; eGs[tg] = expf(G); decs[tg] = expf(GL - G);
        if (tg == 63) ((float*)((unsigned char*)p.out + DO_EGL))[cgi * 16 + hd] = expf(G);
    }
    __syncthreads();
    {
        const int t = tid >> 3, part = tid & 7; float* qp = qf + t * 132 + part * 16; float* kp = kf + t * 132 + part * 16;
        f32x4 qv[4], kv[4]; float sq = 0.f, sk = 0.f;
#pragma unroll
        for (int i = 0; i < 4; ++i) { qv[i] = *(const f32x4*)(qp + 4 * i); kv[i] = *(const f32x4*)(kp + 4 * i);
            sq += qv[i][0] * qv[i][0] + qv[i][1] * qv[i][1] + qv[i][2] * qv[i][2] + qv[i][3] * qv[i][3]; sk += kv[i][0] * kv[i][0] + kv[i][1] * kv[i][1] + kv[i][2] * kv[i][2] + kv[i][3] * kv[i][3]; }
        qk[tid] = sq; qk[512 + tid] = sk;
        __syncthreads();
        const f32x4 a0 = *(const f32x4*)(qk + t * 8), a1 = *(const f32x4*)(qk + t * 8 + 4), b0 = *(const f32x4*)(qk + 512 + t * 8), b1 = *(const f32x4*)(qk + 512 + t * 8 + 4);
        const float s1 = rsqrtf(a0[0] + a0[1] + a0[2] + a0[3] + a1[0] + a1[1] + a1[2] + a1[3] + 1e-6f) * 0.08838834764831845f;
        const float s2 = rsqrtf(b0[0] + b0[1] + b0[2] + b0[3] + b1[0] + b1[1] + b1[2] + b1[3] + 1e-6f);
#pragma unroll
        for (int i = 0; i < 4; ++i) { *(f32x4*)(qp + 4 * i) = qv[i] * s1; *(f32x4*)(kp + 4 * i) = kv[i] * s2; }
    }
    __syncthreads();
    { const int mat = wid >> 2, ti = (wid >> 1) & 1, tj = wid & 1; float* dstm = mat ? qk : am;
      if (ti == 0 && tj == 1) {
#pragma unroll
          for (int i = 0; i < 16; ++i) dstm[crow(i, h) * 68 + 32 + r] = 0.f;
      } else {
          const float* A = mat ? qf : kf; f32x16 acc;
#pragma unroll
          for (int i = 0; i < 16; ++i) acc[i] = 0.f;
#pragma unroll
          for (int ks = 0; ks < 8; ++ks) acc = MFMA32(ld8f(A + (ti * 32 + r) * 132 + ks * 16 + h * 8), ld8f(kf + (tj * 32 + r) * 132 + ks * 16 + h * 8), acc);
#pragma unroll
          for (int i = 0; i < 16; ++i) { const int t = ti * 32 + crow(i, h), s = tj * 32 + r;
              const bool keep = mat ? (s <= t) : (s < t); const float d = keep ? __expf(Gs[t] - Gs[s]) : 0.f;
              dstm[t * 68 + s] = mat ? acc[i] * d : betas[t] * acc[i] * d; }
      } }
    __syncthreads();
    if (tid >= 64) {
        emit_frags(tid - 64, blob + 32768, 2, 4, [&](int row, int col) { return qk[row * 68 + col]; }, 448);
        emit_frags(tid - 64, blob + 16384, 2, 8, [&](int row, int col) { return eGs[row] * qf[row * 132 + col]; }, 448);
        emit_frags(tid - 64, blob + 40960, 4, 4, [&](int row, int col) { return kf[col * 132 + row] * decs[col]; }, 448);
    }
    if (tid < 64) {
        const int b0 = (tid >> 4) * 16, col = tid & 15; float a[120], x[16];
#pragma unroll
        for (int i = 1; i < 16; ++i)
#pragma unroll
            for (int s2 = 0; s2 < i; ++s2) a[i * (i - 1) / 2 + s2] = am[(b0 + i) * 68 + b0 + s2];
#pragma unroll
        for (int i = 0; i < 16; ++i) { float v = (i == col) ? 1.f : 0.f;
#pragma unroll
            for (int s2 = 0; s2 < i; ++s2) v -= a[i * (i - 1) / 2 + s2] * x[s2];
            x[i] = v; tm[(b0 + i) * 68 + b0 + col] = v; }
        asm volatile("s_waitcnt lgkmcnt(0)" ::: "memory");
        const int r16 = r & 15;
#pragma unroll
        for (int B = 0; B < 2; ++B) {
            const int c0 = 32 * B; f32x16 mm, tt;
#pragma unroll
            for (int i = 0; i < 16; ++i) { mm[i] = 0.f; tt[i] = 0.f; }
            float bv[8];
#pragma unroll
            for (int j = 0; j < 8; ++j) bv[j] = tm[(c0 + 8 * h + j) * 68 + c0 + r16];
            mm = MFMA32(ld8f(am + (c0 + 16 + r16) * 68 + c0 + 8 * h), pack8(bv[0], bv[1], bv[2], bv[3], bv[4], bv[5], bv[6], bv[7]), mm);
            const float* tp = tm + (c0 + 16 + r16) * 68 + c0 + 16 + 4 * h; const f32x4 lo = *(const f32x4*)tp, hi = *(const f32x4*)(tp + 8);
            tt = MFMA32(pack8(lo[0], lo[1], lo[2], lo[3], hi[0], hi[1], hi[2], hi[3]), pack_step(mm, 0), tt);
#pragma unroll
            for (int i = 0; i < 8; ++i) if (r < 16) tm[(c0 + 16 + crow(i, h)) * 68 + c0 + r] = -tt[i];
        }
        asm volatile("s_waitcnt lgkmcnt(0)" ::: "memory");
    }
    if (wid == 0) {
        f32x16 m1;
#pragma unroll
        for (int i = 0; i < 16; ++i) m1[i] = 0.f;
#pragma unroll
        for (int ks = 0; ks < 2; ++ks) { float bv[8];
#pragma unroll
            for (int j = 0; j < 8; ++j) bv[j] = tm[(ks * 16 + 8 * h + j) * 68 + r];
            m1 = MFMA32(ld8f(am + (32 + r) * 68 + ks * 16 + 8 * h), pack8(bv[0], bv[1], bv[2], bv[3], bv[4], bv[5], bv[6], bv[7]), m1); }
        f32x16 t21;
#pragma unroll
        for (int i = 0; i < 16; ++i) t21[i] = 0.f;
#pragma unroll
        for (int s2 = 0; s2 < 2; ++s2) { const float* tp = tm + (32 + r) * 68 + 32 + 16 * s2 + 4 * h; const f32x4 lo = *(const f32x4*)tp, hi = *(const f32x4*)(tp + 8);
            t21 = MFMA32(pack8(lo[0], lo[1], lo[2], lo[3], hi[0], hi[1], hi[2], hi[3]), pack_step(m1, s2), t21); }
#pragma unroll
        for (int i = 0; i < 16; ++i) tm[(32 + crow(i, h)) * 68 + r] = -t21[i];
    }
    __syncthreads();
    { const int nt = wid & 3, mat = wid >> 2; const float* src = mat ? vf : kf;
      f32x16 acc0, acc1;
#pragma unroll
      for (int i = 0; i < 16; ++i) { acc0[i] = 0.f; acc1[i] = 0.f; }
#pragma unroll
      for (int ks = 0; ks < 4; ++ks) { float bv[8];
#pragma unroll
          for (int j = 0; j < 8; ++j) { const int s = ks * 16 + 8 * h + j; bv[j] = src[s * 132 + nt * 32 + r] * (mat ? betas[s] : betas[s] * eGs[s]); }
          const bf16x8 b = pack8(bv[0], bv[1], bv[2], bv[3], bv[4], bv[5], bv[6], bv[7]);
          const bf16x8 t0 = ld8f(tm + r * 68 + ks * 16 + 8 * h), t1 = ld8f(tm + (32 + r) * 68 + ks * 16 + 8 * h);
          if (mat) { acc0 = MFMA32(t0, b, acc0); acc1 = MFMA32(t1, b, acc1); }
          else { acc0 = MFMA32(b, t0, acc0); acc1 = MFMA32(b, t1, acc1); } }
      if (mat) {
          unsigned char* d0 = blob + 57344 + ((size_t)((0 * 4 + nt) * 64 + lane)) * 32; unsigned char* d1 = blob + 57344 + ((size_t)((1 * 4 + nt) * 64 + lane)) * 32;
          *(bf16x8*)d0 = pack_step(acc0, 0); *(bf16x8*)(d0 + 16) = pack_step(acc0, 1);
          *(bf16x8*)d1 = pack_step(acc1, 0); *(bf16x8*)(d1 + 16) = pack_step(acc1, 1);
      } else {
#pragma unroll
          for (int i = 0; i < 16; ++i) { acc0[i] = -acc0[i]; acc1[i] = -acc1[i]; }
#pragma unroll
          for (int s2 = 0; s2 < 2; ++s2) {
              *(bf16x8*)(blob + ((size_t)((0 * 8 + 2 * nt + s2) * 64 + lane)) * 16) = pack_step(acc0, s2);
              *(bf16x8*)(blob + ((size_t)((1 * 8 + 2 * nt + s2) * 64 + lane)) * 16) = pack_step(acc1, s2); }
      } }
    __syncthreads();
}

struct PreM { u32x4 qr[2], kr[2], vr[4]; float mi, mf; };
DI void ml_issue(const Params& p, int cgi, int hd, int tid, PreM& pre) {
    const int row0 = cgi * 64; const bf16_t* pa = (const bf16_t*)(p.ws + OFF_PA); const float* gates = (const float*)((unsigned char*)p.out + DO_GATES);
#pragma unroll
    for (int it = 0; it < 2; ++it) { const int idx = tid + 512 * it, t = idx >> 4, cgp = idx & 15;
        pre.qr[it] = *(const u32x4*)(pa + (size_t)(row0 + t) * NA + 6144 + hd * 128 + cgp * 8); pre.kr[it] = *(const u32x4*)(pa + (size_t)(row0 + t) * NA + 7168 + hd * 128 + cgp * 8); }
#pragma unroll
    for (int it = 0; it < 4; ++it) { const int idx = tid + 512 * it, t = idx >> 5, cgp = idx & 31; pre.vr[it] = *(const u32x4*)(pa + (size_t)(row0 + t) * NA + 8192 + hd * 256 + cgp * 8); }
    if (tid < 64) { pre.mi = gates[(size_t)(row0 + tid) * 64 + 32 + hd]; pre.mf = gates[(size_t)(row0 + tid) * 64 + 40 + hd]; }
}
DI void prep_ml(const Params& p, unsigned char* smem, int cgi, int hd, PreM& pre, int ncgi, int nhd, bool has_next) {
    int tid_ = threadIdx.x; asm volatile("" : "+v"(tid_));
    const int tid = tid_, lane = tid & 63, wid = tid >> 6, r = lane & 31, h = lane >> 5;
    float* qf = (float*)smem; float* kf = qf + 64 * 132; bf16_t* vb = (bf16_t*)(smem + 67584); float* pm = (float*)(smem + 101376); float* sc = (float*)(smem + 153600);
    float* as_ = sc; float* pms = sc + 64; float* wend = sc + 128;
    const int row0 = cgi * 64; const bf16_t* pa = (const bf16_t*)(p.ws + OFF_PA); const float* gates = (const float*)((unsigned char*)p.out + DO_GATES);
    unsigned char* blob = (unsigned char*)p.out + DO_PREPM + (size_t)midx(cgi, hd) * BLOB;
#pragma unroll
    for (int it = 0; it < 2; ++it) { const int idx = tid + 512 * it, t = idx >> 4, cgp = idx & 15;
        const u32x4 qr = pre.qr[it], kr = pre.kr[it];
        f32x4 a, b, c2, d; const float ks = 0.08838834764831845f;
        a[0] = __uint_as_float(qr[0] << 16); a[1] = __uint_as_float(qr[0] & 0xffff0000u); a[2] = __uint_as_float(qr[1] << 16); a[3] = __uint_as_float(qr[1] & 0xffff0000u);
        b[0] = __uint_as_float(qr[2] << 16); b[1] = __uint_as_float(qr[2] & 0xffff0000u); b[2] = __uint_as_float(qr[3] << 16); b[3] = __uint_as_float(qr[3] & 0xffff0000u);
        c2[0] = ks * __uint_as_float(kr[0] << 16); c2[1] = ks * __uint_as_float(kr[0] & 0xffff0000u); c2[2] = ks * __uint_as_float(kr[1] << 16); c2[3] = ks * __uint_as_float(kr[1] & 0xffff0000u);
        d[0] = ks * __uint_as_float(kr[2] << 16); d[1] = ks * __uint_as_float(kr[2] & 0xffff0000u); d[2] = ks * __uint_as_float(kr[3] << 16); d[3] = ks * __uint_as_float(kr[3] & 0xffff0000u);
        *(f32x4*)(qf + t * 132 + cgp * 8) = a; *(f32x4*)(qf + t * 132 + cgp * 8 + 4) = b; *(f32x4*)(kf + t * 132 + cgp * 8) = c2; *(f32x4*)(kf + t * 132 + cgp * 8 + 4) = d; }
#pragma unroll
    for (int it = 0; it < 4; ++it) { const int idx = tid + 512 * it, t = idx >> 5, cgp = idx & 31;
        *(u32x4*)(vb + t * 264 + cgp * 8) = pre.vr[it]; }
    const float mi = pre.mi, mf = pre.mf;
    if (has_next) ml_issue(p, ncgi, nhd, tid, pre);
    if (tid < 64) {
        const float logi = mi + p.b_i[hd]; const float logf = -softplus_f(-(mf + p.b_f[hd]));
        float b = logf;
#pragma unroll
        for (int o = 1; o < 64; o <<= 1) { const float t2 = __shfl_up(b, o); if (lane >= o) b += t2; }
        const float a = logi - b; float px = a;
#pragma unroll
        for (int o = 1; o < 64; o <<= 1) { const float t2 = __shfl_up(px, o); if (lane >= o) px = fmaxf(px, t2); }
        const float p63 = __shfl(px, 63);
        as_[tid] = a; pms[tid] = px; wend[tid] = expf(a - p63);
        ((float*)((unsigned char*)p.out + DO_MB))[(size_t)(row0 + tid) * 8 + hd] = b; ((float*)((unsigned char*)p.out + DO_MDMAX))[(size_t)(row0 + tid) * 8 + hd] = b + px;
    }
    __syncthreads();
    if (wid < 4) {
        const int ti = wid >> 1, tj = wid & 1;
        if (ti == 0 && tj == 1) {
#pragma unroll
            for (int i = 0; i < 16; ++i) pm[crow(i, h) * 68 + 32 + r] = 0.f;
        } else { f32x16 acc;
#pragma unroll
            for (int i = 0; i < 16; ++i) acc[i] = 0.f;
#pragma unroll
            for (int ks = 0; ks < 8; ++ks) acc = MFMA32(ld8f(qf + (ti * 32 + r) * 132 + ks * 16 + h * 8), ld8f(kf + (tj * 32 + r) * 132 + ks * 16 + h * 8), acc);
#pragma unroll
            for (int i = 0; i < 16; ++i) { const int t = ti * 32 + crow(i, h), s = tj * 32 + r; pm[t * 68 + s] = (s <= t) ? acc[i] * __expf(as_[s] - pms[t]) : 0.f; }
        }
    } else if (tid < 256 + 128) { const int k = tid - 256; float a = 0.f;
        for (int s = 0; s < 64; ++s) a += wend[s] * kf[s * 132 + k];
        ((float*)((unsigned char*)p.out + DO_KN))[((size_t)cgi * 8 + hd) * 128 + k] = a; }
    emit_frags(tid, blob, 2, 8, [&](int row, int col) { return qf[row * 132 + col]; });
    emit_frags(tid, blob + 24576, 4, 4, [&](int row, int col) { return kf[col * 132 + row] * wend[col]; });
    for (int idx = tid; idx < 8 * 4 * 64; idx += 512) { const int f = idx >> 6, l = idx & 63, nt = f >> 2, ks = f & 3, c = l & 31, hh = l >> 5;
        const int sb = (ks >> 1) * 32 + (ks & 1) * 16 + 4 * hh; bf16x8 o;
#pragma unroll
        for (int j = 0; j < 8; ++j) o[j] = (short)vb[(sb + 8 * (j >> 2) + (j & 3)) * 264 + nt * 32 + c];
        *(bf16x8*)(blob + 40960 + (size_t)idx * 16) = o; }
    __syncthreads();
    if (tid < 64) { float a = 0.f; for (int s = 0; s < 64; ++s) a += pm[tid * 68 + s]; ((float*)((unsigned char*)p.out + DO_MRS))[(size_t)(row0 + tid) * 8 + hd] = a; }
    emit_frags(tid, blob + 16384, 2, 4, [&](int row, int col) { return pm[row * 68 + col]; });
    __syncthreads();
}

DI void lds_copy_kb(LAS unsigned char* lbuf, const unsigned char* g, int nkb, int wid, int lane) {
    for (int kb = wid; kb < nkb; kb += 8)
        __builtin_amdgcn_global_load_lds((const unsigned*)(g + (size_t)kb * 1024 + lane * 16), (LAS unsigned*)(lbuf + kb * 1024), 16, 0, 0);
}
#define WAIT_ALL_VM() asm volatile("s_waitcnt vmcnt(0)" ::: "memory")
template <int NP> DI void ldp_gdn(u32x4 (&R)[NP], const unsigned char* g, int lw, int lane) {
    const unsigned lo = (unsigned)lane * 16u;
#pragma unroll
    for (int j = 0; j < NP; ++j) { const unsigned char* gj = g + (size_t)((lw * NP + j) * 1024); R[j] = *(const u32x4*)(gj + lo); } }
template <int NP> DI void ldp_ml(u32x4 (&R)[NP], const unsigned char* g, int half, int lw, int lane) {
    const unsigned lo = (unsigned)lane * 16u;
#pragma unroll
    for (int j = 0; j < NP; ++j) { const int kb = lw * NP + j; const unsigned char* gj = g + (size_t)((kb < 40 ? 0 : half * 16384) + kb * 1024); R[j] = *(const u32x4*)(gj + lo); } }
template <int NP> DI void stp(const u32x4 (&R)[NP], LAS unsigned char* l, int lw, int lane) {
#pragma unroll
    for (int j = 0; j < NP; ++j) *(LAS u32x4*)(l + ((lw * NP + j) * 64 + lane) * 16) = R[j]; }

DI void scan_gdn(const Params& p, unsigned char* smem, int seq, int hd) {
    int tid_ = threadIdx.x; asm volatile("" : "+v"(tid_));
    const int tid = tid_, lane = tid & 63, wid = __builtin_amdgcn_readfirstlane(tid >> 6), r = lane & 31, h = lane >> 5, w = wid;
    const int nch = seq < 2 ? 128 : 1, cg0 = seq < 2 ? seq * 128 : 256 + (seq - 2);
    LAS unsigned char* lds = (LAS unsigned char*)smem;
    const unsigned char* blob0 = p.ws + OFF_PREPG + (size_t)gidx(cg0, hd) * BLOB;
    const float* egl = (const float*)((unsigned char*)p.out + DO_EGL);
    const int sbase = (4 * h * 128 + 32 * (w & 3) + r) * 4;
    __syncthreads();
    if (seq >= 2) { lds_copy_kb(lds + BLOB, (const unsigned char*)(p.sg + ((size_t)(seq - 2) * 16 + hd) * 16384), 64, wid, lane); WAIT_ALL_VM(); }
    __syncthreads();
    if (w < 4) {
        f32x16 S[4];
        if (seq >= 2) {
#pragma unroll
            for (int kt = 0; kt < 4; ++kt)
#pragma unroll
                for (int i = 0; i < 16; ++i) S[kt][i] = *(const LAS float*)(lds + BLOB + sbase + (32 * kt + (i & 3) + 8 * (i >> 2)) * 512);
        } else {
#pragma unroll
            for (int kt = 0; kt < 4; ++kt)
#pragma unroll
                for (int i = 0; i < 16; ++i) S[kt][i] = 0.f;
        }
        float eg_next = egl[cg0 * 16 + hd];
        __syncthreads();
        __syncthreads();
        for (int c = 0; c < nch; ++c) {
            const int cur = c & 1; const float eg = eg_next;
            if (c + 1 < nch) eg_next = egl[(cg0 + c + 1) * 16 + hd];
            const LAS unsigned char* buf = lds + cur * BLOB;
            f32x16 U[2], O[2];
#pragma unroll
            for (int mt = 0; mt < 2; ++mt) {
                const LAS bf16x8* up = (const LAS bf16x8*)(buf + 57344 + ((mt * 4 + w) * 64 + lane) * 32);
                const bf16x8 u0 = up[0], u1 = up[1];
#pragma unroll
                for (int i = 0; i < 8; ++i) { U[mt][i] = bf2f((bf16_t)u0[i]); U[mt][8 + i] = bf2f((bf16_t)u1[i]); O[mt][i] = 0.f; O[mt][8 + i] = 0.f; }
            }
#define FRG(off) (*(const LAS bf16x8*)(buf + (off) + lane * 16))
            bf16x8 fcur[6], fnxt[6];
            fcur[0] = FRG(0); fcur[1] = FRG(16384); fcur[2] = FRG(8192); fcur[3] = FRG(24576);
#pragma unroll
            for (int ks = 0; ks < 8; ++ks) {
                if (ks < 7) { fnxt[0] = FRG((ks + 1) * 1024); fnxt[1] = FRG(16384 + (ks + 1) * 1024); fnxt[2] = FRG(8192 + (ks + 1) * 1024); fnxt[3] = FRG(24576 + (ks + 1) * 1024); }
                else { fnxt[0] = FRG(32768); fnxt[1] = FRG(32768 + 4096); fnxt[2] = FRG(40960); fnxt[3] = FRG(40960 + 4096); fnxt[4] = FRG(40960 + 8192); fnxt[5] = FRG(40960 + 12288); }
                const bf16x8 sf = pack_step(S[ks >> 1], ks & 1);
                U[0] = MFMA32(fcur[0], sf, U[0]); O[0] = MFMA32(fcur[1], sf, O[0]); U[1] = MFMA32(fcur[2], sf, U[1]); O[1] = MFMA32(fcur[3], sf, O[1]);
                __builtin_amdgcn_sched_barrier(0);
#pragma unroll
                for (int i = 0; i < 6; ++i) fcur[i] = fnxt[i];
            }
#pragma unroll
            for (int kt = 0; kt < 4; ++kt)
#pragma unroll
                for (int i = 0; i < 16; ++i) S[kt][i] *= eg;
#pragma unroll
            for (int ks = 0; ks < 4; ++ks) {
                if (ks < 3) { fnxt[0] = FRG(32768 + (ks + 1) * 1024); fnxt[1] = FRG(32768 + 4096 + (ks + 1) * 1024);
#pragma unroll
                    for (int kt = 0; kt < 4; ++kt) fnxt[2 + kt] = FRG(40960 + kt * 4096 + (ks + 1) * 1024); }
                const bf16x8 uf = pack_step(U[ks >> 1], ks & 1);
                O[0] = MFMA32(fcur[0], uf, O[0]); O[1] = MFMA32(fcur[1], uf, O[1]);
#pragma unroll
                for (int kt = 0; kt < 4; ++kt) S[kt] = MFMA32(fcur[2 + kt], uf, S[kt]);
                __builtin_amdgcn_sched_barrier(0);
#pragma unroll
                for (int i = 0; i < 6; ++i) fcur[i] = fnxt[i];
            }
#undef FRG
            unsigned long long ob = (unsigned long long)(oraw_blk(p, gidx(cg0 + c, hd)) + (4 * h) * 128 + 32 * w + r);
            asm volatile("" : "+v"(ob));
#pragma unroll
            for (int mt = 0; mt < 2; ++mt)
#pragma unroll
                for (int i = 0; i < 16; ++i) *(GAS bf16_t*)(ob + (size_t)(32 * mt + (i & 3) + 8 * (i >> 2)) * 256) = f2bf(O[mt][i]);
            __syncthreads();
        }
#pragma unroll
        for (int kt = 0; kt < 4; ++kt)
#pragma unroll
            for (int i = 0; i < 16; ++i) *(LAS float*)(lds + sbase + (32 * kt + (i & 3) + 8 * (i >> 2)) * 512) = S[kt][i];
    } else {
        const int lw = w - 4;
        if (nch == 1) {
            u32x4 Ra[18];
            ldp_gdn(Ra, blob0, lw, lane);
            __syncthreads();
            stp(Ra, lds, lw, lane);
            __syncthreads();
            __syncthreads();
        } else {
        u32x4 Ra[18], Rb[18];
        const int last = nch - 1;
#define GBLOB(cc) (blob0 + (size_t)((cc) < last ? (cc) : last) * BLOB)
        ldp_gdn(Ra, blob0, lw, lane);
        __syncthreads();
        stp(Ra, lds, lw, lane);
        ldp_gdn(Rb, GBLOB(1), lw, lane);
        ldp_gdn(Ra, GBLOB(2), lw, lane);
        __syncthreads();
        for (int c = 0; c < nch; c += 2) {
            stp(Rb, lds + BLOB, lw, lane);
            ldp_gdn(Rb, GBLOB(c + 3), lw, lane);
            __syncthreads();
            if (c + 1 < nch) {
                stp(Ra, lds, lw, lane);
                ldp_gdn(Ra, GBLOB(c + 4), lw, lane);
                __syncthreads();
            }
        }
#undef GBLOB
            }
    }
    {   float* dst = p.out + (seq < 2 ? O_GDN_P + ((size_t)seq * 16 + hd) * 16384 : O_GDN_S + ((size_t)(seq - 2) * 16 + hd) * 16384);
        __syncthreads();
        for (int i = tid; i < 4096; i += 512) *(f32x4*)(dst + i * 4) = *(const LAS f32x4*)(lds + i * 16);
        __syncthreads();
    }
}

DI void scan_ml(const Params& p, unsigned char* smem, int seq, int hd, int half) {
    int tid_ = threadIdx.x; asm volatile("" : "+v"(tid_));
    const int tid = tid_, lane = tid & 63, wid = __builtin_amdgcn_readfirstlane(tid >> 6), r = lane & 31, h = lane >> 5, w = wid;
    const int nch = seq < 2 ? 128 : 1, cg0 = seq < 2 ? seq * 128 : 256 + (seq - 2);
    LAS unsigned char* lds = (LAS unsigned char*)smem; float* scr = (float*)(smem + 147456) + wid * 128;
    const unsigned char* blob0 = (const unsigned char*)p.out + DO_PREPM + (size_t)midx(cg0, hd) * BLOB;
    bf16_t* num = (bf16_t*)((unsigned char*)p.out + DO_NUM);
    const float* mbp = (const float*)((unsigned char*)p.out + DO_MB); const float* mdp = (const float*)((unsigned char*)p.out + DO_MDMAX); const float* knp = (const float*)((unsigned char*)p.out + DO_KN);
    float* ncs = (float*)((unsigned char*)p.out + DO_NCS); float* mcs = (float*)((unsigned char*)p.out + DO_MCS);
    const bool nwave = (w == 4) && (half == 0);
    float m = 0.f;
    if (seq >= 2) m = p.sm[(seq - 2) * 8 + hd];
    const int sbase = (4 * h * 128 + 32 * (w & 3) + r) * 4;
    __syncthreads();
    if (seq >= 2) {
        const unsigned char* C0 = (const unsigned char*)(p.sc + ((size_t)(seq - 2) * 8 + hd) * 32768) + half * 512;
        for (int kb = wid; kb < 64; kb += 8)
            __builtin_amdgcn_global_load_lds((const unsigned*)(C0 + (size_t)(2 * kb + (lane >> 5)) * 1024 + (lane & 31) * 16), (LAS unsigned*)(lds + BLOB + kb * 1024), 16, 0, 0);
        WAIT_ALL_VM();
    }
    __syncthreads();
    float bt_n = mbp[((size_t)cg0 * 64 + lane) * 8 + hd], dm_n = mdp[((size_t)cg0 * 64 + lane) * 8 + hd];
    if (w < 4) {
        f32x16 C[4];
        if (seq >= 2) {
#pragma unroll
            for (int kt = 0; kt < 4; ++kt)
#pragma unroll
                for (int i = 0; i < 16; ++i) C[kt][i] = *(const LAS float*)(lds + BLOB + sbase + (32 * kt + (i & 3) + 8 * (i >> 2)) * 512);
        } else {
#pragma unroll
            for (int kt = 0; kt < 4; ++kt)
#pragma unroll
                for (int i = 0; i < 16; ++i) C[kt][i] = 0.f;
        }
        __syncthreads();
        __syncthreads();
        for (int c = 0; c < nch; ++c) {
            const int cur = c & 1; const int cgi = cg0 + c;
            const float bt = bt_n, dm = dm_n;
            if (c + 1 < nch) { bt_n = mbp[((size_t)(cgi + 1) * 64 + lane) * 8 + hd]; dm_n = mdp[((size_t)(cgi + 1) * 64 + lane) * 8 + hd]; }
            const float bL = __shfl(bt, 63), E = __shfl(dm, 63);
            const float inter = bt + m, mtv = fmaxf(inter, dm), wq = __expf(inter - mtv), rr = __expf(dm - mtv);
            const float m_new = __shfl(mtv, 63), wC = __expf(bL + m - m_new), sE = __expf(E - m_new);
            const LAS unsigned char* buf = lds + cur * BLOB;
            scr[lane] = wq; scr[64 + lane] = rr;
#define FRG(off) (*(const LAS bf16x8*)(buf + (off) + lane * 16))
            bf16x8 Vf[4];
#pragma unroll
            for (int ks = 0; ks < 4; ++ks) Vf[ks] = FRG(40960 + (w * 4 + ks) * 1024);
            unsigned long long ob = (unsigned long long)(num + (size_t)midx(cgi, hd) * 16384 + (4 * h) * 256 + half * 128 + 32 * w + r);
            asm volatile("" : "+v"(ob));
            const float* scrh = scr + 4 * h;
            f32x16 QC[2], PV[2];
#pragma unroll
            for (int i = 0; i < 16; ++i) { QC[0][i] = 0.f; QC[1][i] = 0.f; PV[0][i] = 0.f; PV[1][i] = 0.f; }
            bf16x8 fcur[4], fnxt[4];
            fcur[0] = FRG(0); fcur[1] = FRG(8192); fcur[2] = FRG(16384); fcur[3] = FRG(16384 + 4096);
#pragma unroll
            for (int ks = 0; ks < 8; ++ks) {
                if (ks < 7) { fnxt[0] = FRG((ks + 1) * 1024); fnxt[1] = FRG(8192 + (ks + 1) * 1024); if (ks < 3) { fnxt[2] = FRG(16384 + (ks + 1) * 1024); fnxt[3] = FRG(16384 + 4096 + (ks + 1) * 1024); } }
                else { fnxt[0] = FRG(24576); fnxt[1] = FRG(24576 + 4096); fnxt[2] = FRG(24576 + 8192); fnxt[3] = FRG(24576 + 12288); }
                const bf16x8 cf = pack_step(C[ks >> 1], ks & 1);
                QC[0] = MFMA32(fcur[0], cf, QC[0]); QC[1] = MFMA32(fcur[1], cf, QC[1]);
                if (ks < 4) { PV[0] = MFMA32(fcur[2], Vf[ks], PV[0]); PV[1] = MFMA32(fcur[3], Vf[ks], PV[1]); }
                __builtin_amdgcn_sched_barrier(0);
#pragma unroll
                for (int i = 0; i < 4; ++i) fcur[i] = fnxt[i];
            }
#pragma unroll
            for (int kt = 0; kt < 4; ++kt)
#pragma unroll
                for (int i = 0; i < 16; ++i) C[kt][i] *= wC;
#pragma unroll
            for (int ks = 0; ks < 4; ++ks) { float f[8];
#pragma unroll
                for (int j = 0; j < 8; ++j) f[j] = sE * bf2f((bf16_t)Vf[ks][j]);
                Vf[ks] = pack8(f[0], f[1], f[2], f[3], f[4], f[5], f[6], f[7]); }
#pragma unroll
            for (int ks = 0; ks < 4; ++ks) {
                if (ks < 3) {
#pragma unroll
                    for (int kt = 0; kt < 4; ++kt) fnxt[kt] = FRG(24576 + kt * 4096 + (ks + 1) * 1024); }
#pragma unroll
                for (int kt = 0; kt < 4; ++kt) C[kt] = MFMA32(fcur[kt], Vf[ks], C[kt]);
                __builtin_amdgcn_sched_barrier(0);
#pragma unroll
                for (int i = 0; i < 4; ++i) fcur[i] = fnxt[i];
            }
#undef FRG
#pragma unroll
            for (int mt = 0; mt < 2; ++mt)
#pragma unroll
                for (int i = 0; i < 16; ++i) { const int t0 = 32 * mt + (i & 3) + 8 * (i >> 2);
                    *(GAS bf16_t*)(ob + (size_t)t0 * 512) = f2bf(scrh[t0] * QC[mt][i] + scrh[64 + t0] * PV[mt][i]); }
            m = m_new;
            __syncthreads();
        }
#pragma unroll
        for (int kt = 0; kt < 4; ++kt)
#pragma unroll
            for (int i = 0; i < 16; ++i) *(LAS float*)(lds + sbase + (32 * kt + (i & 3) + 8 * (i >> 2)) * 512) = C[kt][i];
    } else {
        const int lw = w - 4;
        float n0 = 0.f, n1 = 0.f, k0_n = 0.f, k1_n = 0.f;
        if (nwave) { if (seq >= 2) { n0 = p.sn[((size_t)(seq - 2) * 8 + hd) * 128 + lane]; n1 = p.sn[((size_t)(seq - 2) * 8 + hd) * 128 + 64 + lane]; }
            k0_n = knp[((size_t)cg0 * 8 + hd) * 128 + lane]; k1_n = knp[((size_t)cg0 * 8 + hd) * 128 + 64 + lane]; }
        auto nstep = [&](int c) {
            const int cgi = cg0 + c;
            const float bt = bt_n, dm = dm_n, k0 = k0_n, k1 = k1_n;
            if (c + 1 < nch) { bt_n = mbp[((size_t)(cgi + 1) * 64 + lane) * 8 + hd]; dm_n = mdp[((size_t)(cgi + 1) * 64 + lane) * 8 + hd];
                k0_n = knp[((size_t)(cgi + 1) * 8 + hd) * 128 + lane]; k1_n = knp[((size_t)(cgi + 1) * 8 + hd) * 128 + 64 + lane]; }
            const float bL = __shfl(bt, 63), E = __shfl(dm, 63);
            const float mtv = fmaxf(bt + m, dm);
            const float m_new = __shfl(mtv, 63), wC = __expf(bL + m - m_new), sE = __expf(E - m_new);
            ncs[((size_t)cgi * 8 + hd) * 128 + lane] = n0; ncs[((size_t)cgi * 8 + hd) * 128 + 64 + lane] = n1;
            if (lane == 0) mcs[cgi * 8 + hd] = m;
            n0 = wC * n0 + sE * k0; n1 = wC * n1 + sE * k1;
            m = m_new;
        };
        if (nch == 1) {
            u32x4 Ra[14];
            ldp_ml(Ra, blob0, half, lw, lane);
            __syncthreads();
            stp(Ra, lds, lw, lane);
            __syncthreads();
            if (nwave) nstep(0);
            __syncthreads();
        } else {
        u32x4 Ra[14], Rb[14];
        const int last = nch - 1;
#define MBLOB(cc) (blob0 + (size_t)((cc) < last ? (cc) : last) * BLOB)
        ldp_ml(Ra, blob0, half, lw, lane);
        __syncthreads();
        stp(Ra, lds, lw, lane);
        ldp_ml(Rb, MBLOB(1), half, lw, lane);
        ldp_ml(Ra, MBLOB(2), half, lw, lane);
        __syncthreads();
        for (int c = 0; c < nch; c += 2) {
            stp(Rb, lds + BLOB, lw, lane);
            ldp_ml(Rb, MBLOB(c + 3), half, lw, lane);
            if (nwave) nstep(c);
            __syncthreads();
            if (c + 1 < nch) {
                stp(Ra, lds, lw, lane);
                ldp_ml(Ra, MBLOB(c + 4), half, lw, lane);
                if (nwave) nstep(c + 1);
                __syncthreads();
            }
        }
        }
#undef MBLOB
        if (nwave) {
            float* dn = p.out + (seq < 2 ? O_N_P + ((size_t)seq * 8 + hd) * 128 : O_N_S + ((size_t)(seq - 2) * 8 + hd) * 128);
            dn[lane] = n0; dn[64 + lane] = n1;
            if (lane == 0) p.out[(seq < 2 ? O_M_P + seq * 8 + hd : O_M_S + (seq - 2) * 8 + hd)] = m;
        }
    }
    {   float* dst = p.out + (seq < 2 ? O_C_P + ((size_t)seq * 8 + hd) * 32768 : O_C_S + ((size_t)(seq - 2) * 8 + hd) * 32768) + half * 128;
        __syncthreads();
        for (int i = tid; i < 4096; i += 512) *(f32x4*)(dst + (i >> 5) * 256 + (i & 31) * 4) = *(const LAS f32x4*)(lds + i * 16);
        __syncthreads();
    }
}

struct TableOrder {
    const unsigned* tab; int n, G, c; bool remap;
    DI bool next(int i, pg8::Unit& u) const {
        const long L = (long)i * G + c; if (L >= n) return false;
        int w = (int)L;
        if (remap) { const int q = n / 8, r = n % 8, xcd = w % 8, off = w / 8; w = (xcd < r ? xcd * (q + 1) : r * (q + 1) + (xcd - r) * q) + off; }
        const unsigned v = tab[w]; u.pm = (int)(v >> 8); u.pn = (int)(v & 255u); return true;
    }
    DI void a_ready(const pg8::Unit&) const {}
    DI void done(const pg8::Unit&) const {}
};
DI void gemm1_units(const Params& p, unsigned char* smem, const unsigned* tab, int n, int G, int c, bool remap) {
    pg8::Gemm g; g.A = (const bf16_t*)(p.ws + OFF_H); g.Bt = (const bf16_t*)(p.ws + OFF_BT1); g.M = NTOK; g.N = N1; g.K = DM;
    TableOrder S; S.tab = tab; S.n = n; S.G = G; S.c = c; S.remap = remap;
    Epi1 E; E.pa = (bf16_t*)(p.ws + OFF_PA); E.pb = (bf16_t*)(p.ws + OFF_PB); E.gates = (float*)((unsigned char*)p.out + DO_GATES);
    pg8::gemm_phase<Epi1, TableOrder, false>((LAS unsigned char*)smem, g, S, E, nullptr);
    __syncthreads();
}
DI void phase1(const Params& p, unsigned char* smem) {
    gemm1_units(p, smem, (const unsigned*)((const unsigned char*)p.out + DO_TABK), NKEPT, (int)gridDim.x, (int)blockIdx.x, true);
}
DI void phase3(const Params& p, unsigned char* smem) {
    const int b = blockIdx.x;
    if (b < 32) { if (p.mode3 & 1) scan_gdn(p, smem, b >> 4, b & 15); }
    else if (b < 64) { if (p.mode3 & 1) { const int i = b - 32; scan_ml(p, smem, i >> 4, (i >> 1) & 7, i & 1); } }
    else {
        if (p.mode3 & 2) for (int it = b - 64; it < 1024; it += gridDim.x - 64) {
            if (it < 512) scan_gdn(p, smem, 2 + (it >> 4), it & 15);
            else { const int i = it - 512; scan_ml(p, smem, 2 + (i >> 4), (i >> 1) & 7, i & 1); }
            __syncthreads();
        }
        __syncthreads();
        if (p.mode3 & 4) gemm1_units(p, smem, (const unsigned*)((const unsigned char*)p.out + DO_TABD), NDEF, (int)gridDim.x - 64, b - 64, false);
    }
}

DI void unpk8(const u32x4 v, float (&f)[8]) {
#pragma unroll
    for (int i = 0; i < 4; ++i) { f[2 * i] = __uint_as_float(v[i] << 16); f[2 * i + 1] = __uint_as_float(v[i] & 0xffff0000u); } }
DI void phase4(const Params& p, unsigned char* smem) {
    int tid_ = threadIdx.x; asm volatile("" : "+v"(tid_));
    const int tid = tid_, lane = tid & 63, wid = tid >> 6;
    const int gw = blockIdx.x * 8 + wid, nw = gridDim.x * 8;
    const bf16_t* num = (const bf16_t*)((const unsigned char*)p.out + DO_NUM);
    const bf16_t* pa = (const bf16_t*)(p.ws + OFF_PA); const bf16_t* pb = (const bf16_t*)(p.ws + OFF_PB);
    const float* mbp = (const float*)((unsigned char*)p.out + DO_MB); const float* mdp = (const float*)((unsigned char*)p.out + DO_MDMAX); const float* mrs = (const float*)((unsigned char*)p.out + DO_MRS);
    const float* ncs = (const float*)((unsigned char*)p.out + DO_NCS); const float* mcs = (const float*)((unsigned char*)p.out + DO_MCS);
    bf16_t* mixed = (bf16_t*)(p.ws + OFF_MIXED);
    const int hm = lane >> 3, sub = lane & 7;
    transpose_tiles(p, smem, tid, true);
    for (int row = gw; row < NTOK; row += nw) {
        const int cgi = row >> 6;
        const bf16_t* orow = oraw_blk(p, gidx(cgi, lane >> 2)) + (row & 63) * 128 + (lane & 3) * 32;
        u32x4 ov[4], zv[4];
#pragma unroll
        for (int i = 0; i < 4; ++i) { ov[i] = *(const u32x4*)(orow + i * 8); zv[i] = *(const u32x4*)(pb + (size_t)row * NB + lane * 32 + i * 8); }
        {
            float ss = 0.f;
#pragma unroll
            for (int i = 0; i < 4; ++i) { float f[8]; unpk8(ov[i], f);
#pragma unroll
                for (int j = 0; j < 8; ++j) ss += f[j] * f[j]; }
            ss += __shfl_xor(ss, 1); ss += __shfl_xor(ss, 2);
            const float rs = rsqrtf(ss * (1.f / 128.f) + 1e-6f);
#pragma unroll
            for (int i = 0; i < 4; ++i) { float f[8], z[8]; unpk8(ov[i], f); unpk8(zv[i], z);
                const f32x4 g0 = *(const f32x4*)(p.gdn_nw + (lane & 3) * 32 + i * 8), g1 = *(const f32x4*)(p.gdn_nw + (lane & 3) * 32 + i * 8 + 4);
                u32x4 o; o[0] = pk2(f[0] * rs * g0[0] * silu_f(z[0]), f[1] * rs * g0[1] * silu_f(z[1])); o[1] = pk2(f[2] * rs * g0[2] * silu_f(z[2]), f[3] * rs * g0[3] * silu_f(z[3]));
                o[2] = pk2(f[4] * rs * g1[0] * silu_f(z[4]), f[5] * rs * g1[1] * silu_f(z[5])); o[3] = pk2(f[6] * rs * g1[2] * silu_f(z[6]), f[7] * rs * g1[3] * silu_f(z[7]));
                *(u32x4*)(mixed + (size_t)row * DM + lane * 32 + i * 8) = o; }
        }
        __builtin_amdgcn_sched_barrier(0);
        u32x4 nv[4], mov[4], mzv[4], qv[2]; f32x4 nn[4];
#pragma unroll
        for (int i = 0; i < 4; ++i) { nv[i] = *(const u32x4*)(num + (size_t)midx(cgi, hm) * 16384 + (row & 63) * 256 + sub * 32 + i * 8); mov[i] = *(const u32x4*)(pb + (size_t)row * NB + 2048 + lane * 32 + i * 8);
            mzv[i] = *(const u32x4*)(pb + (size_t)row * NB + 4096 + lane * 32 + i * 8); nn[i] = *(const f32x4*)(ncs + ((size_t)cgi * 8 + hm) * 128 + sub * 16 + i * 4); }
        qv[0] = *(const u32x4*)(pa + (size_t)row * NA + 6144 + hm * 128 + sub * 16); qv[1] = *(const u32x4*)(pa + (size_t)row * NA + 6144 + hm * 128 + sub * 16 + 8);
        const float mc = mcs[cgi * 8 + hm], bt = mbp[(size_t)row * 8 + hm], dm = mdp[(size_t)row * 8 + hm], rsm = mrs[(size_t)row * 8 + hm];
        {
            float qf8[8], qn = 0.f;
            unpk8(qv[0], qf8); qn += qf8[0] * nn[0][0] + qf8[1] * nn[0][1] + qf8[2] * nn[0][2] + qf8[3] * nn[0][3] + qf8[4] * nn[1][0] + qf8[5] * nn[1][1] + qf8[6] * nn[1][2] + qf8[7] * nn[1][3];
            unpk8(qv[1], qf8); qn += qf8[0] * nn[2][0] + qf8[1] * nn[2][1] + qf8[2] * nn[2][2] + qf8[3] * nn[2][3] + qf8[4] * nn[3][0] + qf8[5] * nn[3][1] + qf8[6] * nn[3][2] + qf8[7] * nn[3][3];
            qn += __shfl_xor(qn, 1); qn += __shfl_xor(qn, 2); qn += __shfl_xor(qn, 4);
            const float inter = bt + mc, mtv = fmaxf(inter, dm), wq = __expf(inter - mtv), rr = __expf(dm - mtv);
            const float den = wq * qn + rr * rsm; const float inv = 1.f / fmaxf(fabsf(den), __expf(-mtv));
            float ss = 0.f;
#pragma unroll
            for (int i = 0; i < 4; ++i) { float f[8]; unpk8(nv[i], f);
#pragma unroll
                for (int j = 0; j < 8; ++j) { const float hv = f[j] * inv; ss += hv * hv; } }
            ss += __shfl_xor(ss, 1); ss += __shfl_xor(ss, 2); ss += __shfl_xor(ss, 4);
            const float rs = rsqrtf(ss * (1.f / 256.f) + 1e-6f) * inv;
#pragma unroll
            for (int i = 0; i < 4; ++i) { float f[8], a[8], z[8]; unpk8(nv[i], f); unpk8(mov[i], a); unpk8(mzv[i], z);
                const f32x4 g0 = *(const f32x4*)(p.ml_nw + sub * 32 + i * 8), g1 = *(const f32x4*)(p.ml_nw + sub * 32 + i * 8 + 4);
                u32x4 o; o[0] = pk2(f[0] * rs * g0[0] * sigm_f(a[0]) * silu_f(z[0]), f[1] * rs * g0[1] * sigm_f(a[1]) * silu_f(z[1]));
                o[1] = pk2(f[2] * rs * g0[2] * sigm_f(a[2]) * silu_f(z[2]), f[3] * rs * g0[3] * sigm_f(a[3]) * silu_f(z[3]));
                o[2] = pk2(f[4] * rs * g1[0] * sigm_f(a[4]) * silu_f(z[4]), f[5] * rs * g1[1] * sigm_f(a[5]) * silu_f(z[5]));
                o[3] = pk2(f[6] * rs * g1[2] * sigm_f(a[6]) * silu_f(z[6]), f[7] * rs * g1[3] * sigm_f(a[7]) * silu_f(z[7]));
                *(u32x4*)(mixed + (size_t)row * DM + 2048 + lane * 32 + i * 8) = o; }
        }
    }
    for (int i = blockIdx.x * 512 + tid; i < 34 * 3 * 6144; i += gridDim.x * 512) {
        const int c = i % 6144, j = (i / 6144) % 3, s = i / (3 * 6144);
        const size_t row = s < 2 ? (size_t)s * 8192 + 8189 + j : (size_t)NPR + (size_t)(s - 2) * 64 + 61 + j;
        const float v = bf2f(pa[row * NA + c]);
        if (s < 2) p.out[O_CONV_P + ((size_t)s * 3 + j) * 6144 + c] = v; else p.out[O_CONV_S + ((size_t)(s - 2) * 3 + j) * 6144 + c] = v;
    }
}

DI void phase6(const Params& p) {
    int tid_ = threadIdx.x; asm volatile("" : "+v"(tid_));
    const int tid = tid_, lane = tid & 63, wid = tid >> 6;
    const int gw = blockIdx.x * 8 + wid, nw = gridDim.x * 8;
    const float* rowss = (const float*)(p.ws + OFF_ROWSS);
    for (int row = gw; row < NTOK; row += nw) {
        float* yr = p.out + (size_t)row * DM; const float rs = rsqrtf(rowss[row] * (1.f / DM) + 1e-6f);
#pragma unroll
        for (int i = 0; i < 16; ++i) { const f32x4 g = *(const f32x4*)(p.final_g + (lane + 64 * i) * 4); f32x4 v = *(const f32x4*)(yr + (lane + 64 * i) * 4);
            v[0] *= rs * g[0]; v[1] *= rs * g[1]; v[2] *= rs * g[2]; v[3] *= rs * g[3]; *(f32x4*)(yr + (lane + 64 * i) * 4) = v; }
    }
}

DI void phase2(const Params& p, unsigned char* smem) {
    const int G = gridDim.x; int it = blockIdx.x;
    {   PreG pre;
        if (it < 4608) gdn_issue(p, it >> 4, it & 15, threadIdx.x, pre);
#pragma unroll 1
        for (; it < 4608; it += G) { const int nit = it + G; prep_gdn(p, smem, it >> 4, it & 15, pre, nit >> 4, nit & 15, nit < 4608); }
    }
    {   PreM pre;
        if (it < 6912) ml_issue(p, (it - 4608) >> 3, (it - 4608) & 7, threadIdx.x, pre);
#pragma unroll 1
        for (; it < 6912; it += G) { const int nit = it + G; prep_ml(p, smem, (it - 4608) >> 3, (it - 4608) & 7, pre, (nit - 4608) >> 3, (nit - 4608) & 7, nit < 6912); }
    }
}
DI void phase5(const Params& p, unsigned char* smem) {
    pg8::Gemm g; g.A = (const bf16_t*)(p.ws + OFF_MIXED); g.Bt = (const bf16_t*)(p.ws + OFF_BT2); g.M = NTOK; g.N = DM; g.K = DM;
    pg8::StaticOrder S; S.init(g.M, g.N, (int)gridDim.x, (int)blockIdx.x);
    Epi2 E; E.xp = p.xp; E.xs = p.xs; E.y = p.out; E.rowss = (float*)(p.ws + OFF_ROWSS);
    pg8::gemm_phase<Epi2, pg8::StaticOrder, false>((LAS unsigned char*)smem, g, S, E, nullptr);
    __syncthreads();
}

__global__ __launch_bounds__(512, 2) void mega(Params p) {
    extern __shared__ __attribute__((aligned(16))) unsigned char smem[];
    cg::grid_group grid = cg::this_grid();
#ifndef PHMASK
#define PHMASK 127
#endif
#ifndef DBLMASK
#define DBLMASK 0
#endif
#define PHASE(i, call) if constexpr ((PHMASK >> (i)) & 1) { if (p.ph_lo <= (i) && (i) <= p.ph_hi) { call; if ((i) < p.ph_hi) grid.sync(); } }
    PHASE(0, phase0(p, smem))
    PHASE(1, phase1(p, smem))
    PHASE(2, phase2(p, smem))
    PHASE(3, phase3(p, smem))
    PHASE(4, phase4(p, smem))
    PHASE(5, phase5(p, smem))
    PHASE(6, phase6(p))
}

#ifndef N_LAUNCH_SPLIT
#define N_LAUNCH_SPLIT 1
#endif
extern "C" void kernel_launch(void* const* d_in, const int* in_sizes, int n_in, void* d_out, int out_size, void* d_ws, size_t ws_size, hipStream_t stream) {
    static int grid = 0;
    if (grid == 0) {
        if (ws_size < WS_END || n_in != 18) { fprintf(stderr, "kernel_launch: workspace %zu < %zu or n_in %d != 18\n", ws_size, (size_t)WS_END, n_in); grid = -1; return; }
        int dev = 0, cus = 0, per_cu = 0;
        (void)hipGetDevice(&dev); (void)hipDeviceGetAttribute(&cus, hipDeviceAttributeMultiprocessorCount, dev);
        (void)hipFuncSetAttribute((const void*)mega, hipFuncAttributeMaxDynamicSharedMemorySize, LDS_BYTES);
        (void)hipOccupancyMaxActiveBlocksPerMultiprocessor(&per_cu, (const void*)mega, 512, LDS_BYTES);
        if (per_cu < 1) { fprintf(stderr, "kernel_launch: occupancy query says %d blocks/CU\n", per_cu); per_cu = 1; }
        (void)hipGetLastError();
        grid = cus;
    }
    if (grid < 0) return;
    Params p{};
    p.xp = (const float*)d_in[0]; p.xs = (const float*)d_in[1]; p.cache = (const float*)d_in[2]; p.sg = (const float*)d_in[3]; p.sc = (const float*)d_in[4];
    p.sn = (const float*)d_in[5]; p.sm = (const float*)d_in[6]; p.norm_g = (const float*)d_in[7]; p.w_in = (const float*)d_in[8]; p.conv_w = (const float*)d_in[9];
    p.a_log = (const float*)d_in[10]; p.dt_bias = (const float*)d_in[11]; p.gdn_nw = (const float*)d_in[12]; p.b_i = (const float*)d_in[13]; p.b_f = (const float*)d_in[14];
    p.ml_nw = (const float*)d_in[15]; p.w_out = (const float*)d_in[16]; p.final_g = (const float*)d_in[17];
    p.out = (float*)d_out; p.ws = (unsigned char*)d_ws; p.mode3 = 7;
#if N_LAUNCH_SPLIT == 1
    p.ph_lo = 0; p.ph_hi = 6;
    void* args[] = {&p};
    hipError_t e = hipLaunchCooperativeKernel((const void*)mega, dim3(grid), dim3(512), args, LDS_BYTES, stream);
    if (e != hipSuccess) fprintf(stderr, "cooperative launch failed: %s (grid %d)\n", hipGetErrorString(e), grid);
#else
    for (int ph = 0; ph <= 6; ++ph) { p.ph_lo = ph; p.ph_hi = ph; const int reps = 1 + ((DBLMASK >> ph) & 1);
        for (int rep = 0; rep < reps; ++rep) hipLaunchKernelGGL(mega, dim3(grid), dim3(512), LDS_BYTES, stream, p);
        if (ph == 3 && (DBLMASK >> 7)) { p.mode3 = (DBLMASK >> 7) & 7; hipLaunchKernelGGL(mega, dim3(grid), dim3(512), LDS_BYTES, stream, p); p.mode3 = 7; } }
#endif
}
```

```cpp
#include <hip/hip_runtime.h>
#include <hip/hip_cooperative_groups.h>
#include <cstdio>
namespace cg = cooperative_groups;
#define N_LAUNCH_SPLIT 1
#define DBLMASK 0
namespace pg8 {
#define PG8_LAS __attribute__((address_space(3)))
typedef unsigned short bf16_t;
typedef short bf16x8 __attribute__((ext_vector_type(8)));
typedef float f32x4 __attribute__((ext_vector_type(4)));
typedef unsigned u32x4 __attribute__((ext_vector_type(4)));
constexpr int BM = 256, BK = 64, HALF = 128, HTB = HALF * BK * 2  , STAGE_BYTES = 8 * HTB, NXCD = 8, WGM = 8;

__host__ __device__ __forceinline__ int lds_byte(int r, int c) { const int st = (r >> 4) * 2 + (c >> 5), rr = r & 15, cc = c & 31, ob = rr * 64 + cc * 2; return st * 1024 + (ob ^ (((ob >> 9) & 1) << 5)); }
__host__ __device__ __forceinline__ void stage_rc(int b, int& R, int& C) { const int st = b / 1024, sb = b % 1024, swz = sb ^ (((sb >> 9) & 1) << 5); R = (st >> 1) * 16 + swz / 64; C = (st & 1) * 32 + (swz % 64) / 2; }
__host__ __device__ __forceinline__ int perm32(int rho) { const int n = rho >> 4, i = rho & 15; return 8 * (i >> 2) + 4 * n + (i & 3); }

struct Unit { int pm, pn; };
struct Gemm { const bf16_t* A; const bf16_t* Bt; int M, N, K; };

struct StaticOrder {
    int nM, nN, nwg, G, c;
    __host__ __device__ void init(int M, int N, int G_, int c_) { nM = M / BM; nN = N / BM; nwg = nM * nN; G = G_; c = c_; }
    __host__ __device__ bool next(int i, Unit& u) const {
        const long L = (long)i * G + c; if (L >= nwg) return false;
        int wgid = (int)L; { const int q = nwg / NXCD, r = nwg % NXCD, xcd = wgid % NXCD, off = wgid / NXCD; wgid = (xcd < r ? xcd * (q + 1) : r * (q + 1) + (xcd - r) * q) + off; }
        const int nig = WGM * nN, gid = wgid / nig, fm = gid * WGM, gsz = (nM - fm) < WGM ? (nM - fm) : WGM;
        u.pm = fm + ((wgid % nig) % gsz); u.pn = (wgid % nig) / gsz; return true;
    }
    __device__ __forceinline__ void a_ready(const Unit&) const {}
    __device__ __forceinline__ void done(const Unit&) const {}
};
template <class Epi, class Sched, bool STAMP = false>
__device__ __forceinline__ void gemm_phase(PG8_LAS unsigned char* lds, const Gemm g, const Sched& S, const Epi& E, unsigned long long* stamps) {
    const int tid = threadIdx.x, wid = __builtin_amdgcn_readfirstlane(tid >> 6), lane = tid & 63, wr = wid >> 2, wc = wid & 3, fr = lane & 15, fq = lane >> 4;
    const int K = g.K, nt = K / BK;
    int ts_lo = 0, ts_hi = 0, nts = 0; const unsigned long long rt_entry = STAMP ? (unsigned long long)wall_clock64() : 0ull;
#define PG8_STAMP() do { if (STAMP && wid == 0 && nts < 64) { const unsigned long long _c = (unsigned long long)clock64(); \
        ts_lo = (lane == nts) ? (int)(unsigned)_c : ts_lo; ts_hi = (lane == nts) ? (int)(unsigned)(_c >> 32) : ts_hi; ++nts; } } while (0)
    PG8_STAMP();
    unsigned voffA[2], voffB[2];
#pragma unroll
    for (int i = 0; i < 2; ++i) { int R, C; stage_rc(tid * 16 + i * 8192, R, C); const int Rb = Epi::PERM ? ((R & ~31) + perm32(R & 31)) : R;
        voffA[i] = (unsigned)(R * K + C) * 2u; voffB[i] = (unsigned)(Rb * K + C) * 2u; }
    const size_t kstep = (size_t)(BK * 2);
    const size_t hstep = (size_t)HALF * K * 2;
    const size_t tstep = 2 * hstep;
    const unsigned ldsw = (unsigned)wid * 1024u;
    const int aoff = lds_byte(wr * 64 + fr, fq * 8), boff = lds_byte(wc * 32 + fr, fq * 8);
#define PG8_SA(b, h) (((b) * 2 + (h)) * HTB)
#define PG8_SB(b, h) ((4 + (b) * 2 + (h)) * HTB)
#define PG8_STAGE(bufoff, gbase, voff) do { _Pragma("unroll") for (int _i = 0; _i < 2; ++_i) \
        __builtin_amdgcn_global_load_lds((const unsigned*)((const char*)(gbase) + (voff)[_i]), (PG8_LAS unsigned*)(lds + (bufoff) + ldsw + _i * 8192), 16, 0, 0); } while (0)
#define PG8_LDA(dst, b, h) do { _Pragma("unroll") for (int m = 0; m < 4; ++m) _Pragma("unroll") for (int k = 0; k < 2; ++k) dst[m][k] = *(const PG8_LAS bf16x8*)(lds + PG8_SA(b, h) + aoff + m * 2048 + k * 1024); } while (0)
#define PG8_LDB(dst, b, h) do { _Pragma("unroll") for (int n = 0; n < 2; ++n) _Pragma("unroll") for (int k = 0; k < 2; ++k) dst[n][k] = *(const PG8_LAS bf16x8*)(lds + PG8_SB(b, h) + boff + n * 2048 + k * 1024); } while (0)
#define PG8_MMA(ai, bj, At, Bt) do { __builtin_amdgcn_s_setprio(1); _Pragma("unroll") for (int m = 0; m < 4; ++m) _Pragma("unroll") for (int n = 0; n < 2; ++n) _Pragma("unroll") for (int k = 0; k < 2; ++k) \
        acc[ai][bj][m][n] = __builtin_amdgcn_mfma_f32_16x16x32_bf16(Bt[n][k], At[m][k], acc[ai][bj][m][n], 0, 0, 0); __builtin_amdgcn_s_setprio(0); } while (0)
#define PG8_WAIT_V(n) asm volatile("s_waitcnt vmcnt(" #n ")" ::: "memory")
#define PG8_WAIT_L(n) asm volatile("s_waitcnt lgkmcnt(" #n ")" ::: "memory")
#define PG8_BAR __builtin_amdgcn_s_barrier()
#define PG8_SCHED __builtin_amdgcn_sched_barrier(0)
    Unit cur, nxt; int ui = 0;
    if (!S.next(0, cur)) return;
    f32x4 acc[2][2][4][2];
#pragma unroll
    for (int a = 0; a < 2; ++a)
#pragma unroll
        for (int b = 0; b < 2; ++b)
#pragma unroll
            for (int m = 0; m < 4; ++m)
#pragma unroll
                for (int n = 0; n < 2; ++n) acc[a][b][m][n] = (f32x4){0.f, 0.f, 0.f, 0.f};
    bf16x8 At[4][2], B0[2][2], B1[2][2];
    const char* cA = (const char*)g.A + (size_t)cur.pm * tstep; const char* cB = (const char*)g.Bt + (size_t)cur.pn * tstep;
    S.a_ready(cur);
    PG8_STAGE(PG8_SB(0, 0), cB, voffB); PG8_STAGE(PG8_SA(0, 0), cA, voffA); PG8_STAGE(PG8_SB(0, 1), cB + hstep, voffB); PG8_STAGE(PG8_SA(0, 1), cA + hstep, voffA);
    if (wr == 1) PG8_BAR;
    PG8_WAIT_V(4); PG8_BAR;
    PG8_STAGE(PG8_SB(1, 0), cB + kstep, voffB); PG8_STAGE(PG8_SA(1, 0), cA + kstep, voffA); PG8_STAGE(PG8_SB(1, 1), cB + hstep + kstep, voffB);
    PG8_WAIT_V(6); PG8_BAR;
    PG8_STAMP();
    for (;;) {
        const bool has_next = S.next(ui + 1, nxt);
        const char* nA = has_next ? (const char*)g.A + (size_t)nxt.pm * tstep : cA; const char* nB = has_next ? (const char*)g.Bt + (size_t)nxt.pn * tstep : cB;
        for (int t = 0; t < nt; t += 2) {
            const bool last = (t == nt - 2);
            const char* a1 = cA + (size_t)(t + 1) * kstep;
            const char* a2 = last ? nA : cA + (size_t)(t + 2) * kstep; const char* b2 = last ? nB : cB + (size_t)(t + 2) * kstep;
            const char* a3 = a2 + kstep; const char* b3 = b2 + kstep;
            if (last && has_next) S.a_ready(nxt);
            PG8_LDB(B0, 0, 0); PG8_SCHED; PG8_LDA(At, 0, 0); PG8_STAGE(PG8_SA(1, 1), a1 + hstep, voffA);
            PG8_WAIT_L(8); PG8_BAR; PG8_WAIT_L(0); PG8_MMA(0, 0, At, B0); PG8_BAR; PG8_SCHED;
            PG8_LDB(B1, 0, 1); PG8_STAGE(PG8_SB(0, 0), b2, voffB);
            PG8_BAR; PG8_WAIT_L(0); PG8_MMA(0, 1, At, B1); PG8_BAR;
            PG8_LDA(At, 0, 1); PG8_STAGE(PG8_SA(0, 0), a2, voffA);
            PG8_BAR; PG8_WAIT_L(0); PG8_MMA(1, 0, At, B0); PG8_BAR; PG8_SCHED;
            PG8_STAGE(PG8_SB(0, 1), b2 + hstep, voffB);
            PG8_WAIT_V(6); PG8_BAR; PG8_MMA(1, 1, At, B1); PG8_BAR;
            PG8_LDB(B0, 1, 0); PG8_SCHED; PG8_LDA(At, 1, 0); PG8_STAGE(PG8_SA(0, 1), a2 + hstep, voffA);
            PG8_WAIT_L(8); PG8_BAR; PG8_WAIT_L(0); PG8_MMA(0, 0, At, B0); PG8_BAR; PG8_SCHED;
            PG8_LDB(B1, 1, 1); PG8_STAGE(PG8_SB(1, 0), b3, voffB);
            PG8_BAR; PG8_WAIT_L(0); PG8_MMA(0, 1, At, B1); PG8_BAR;
            PG8_LDA(At, 1, 1); PG8_STAGE(PG8_SA(1, 0), a3, voffA);
            PG8_BAR; PG8_WAIT_L(0); PG8_MMA(1, 0, At, B0); PG8_BAR; PG8_SCHED;
            PG8_STAGE(PG8_SB(1, 1), b3 + hstep, voffB);
            PG8_WAIT_V(6); PG8_BAR; PG8_MMA(1, 1, At, B1); PG8_BAR;
        }
        PG8_STAMP();
        if constexpr (!Epi::AFTER_DRAIN) { E(acc, cur, wr, wc, fr, fq); S.done(cur); }
        PG8_STAMP();
        if (!has_next) break;
#pragma unroll
        for (int a = 0; a < 2; ++a)
#pragma unroll
            for (int b = 0; b < 2; ++b)
#pragma unroll
                for (int m = 0; m < 4; ++m)
#pragma unroll
                    for (int n = 0; n < 2; ++n) acc[a][b][m][n] = (f32x4){0.f, 0.f, 0.f, 0.f};
        cur = nxt; cA = nA; cB = nB; ++ui;
    }
    PG8_WAIT_V(0);
    if (wr == 0) PG8_BAR;
    PG8_BAR;
    if constexpr (Epi::AFTER_DRAIN) { E.fused(acc, cur, wr, wc, fr, fq, lds, wid, lane); S.done(cur); }
    PG8_STAMP();
    if (STAMP && wid == 0) { stamps[lane] = lane < nts ? (((unsigned long long)(unsigned)ts_hi << 32) | (unsigned)ts_lo) : 0ull;
        if (lane == 62) stamps[62] = rt_entry; if (lane == 63) stamps[63] = (unsigned long long)wall_clock64(); }
#undef PG8_STAMP
#undef PG8_SA
#undef PG8_SB
#undef PG8_STAGE
#undef PG8_LDA
#undef PG8_LDB
#undef PG8_MMA
#undef PG8_WAIT_V
#undef PG8_WAIT_L
#undef PG8_BAR
#undef PG8_SCHED
}
}
using pg8::bf16_t; using pg8::bf16x8; using pg8::f32x4; using pg8::u32x4;
typedef float f32x16 __attribute__((ext_vector_type(16)));
typedef __bf16 bf16x2_t __attribute__((ext_vector_type(2)));
typedef float f32x2_t __attribute__((ext_vector_type(2)));
#define DI __device__ __forceinline__
#define LAS __attribute__((address_space(3)))
#define GAS __attribute__((address_space(1)))
#define MFMA32(a, b, c) __builtin_amdgcn_mfma_f32_32x32x16_bf16((a), (b), (c), 0, 0, 0)

constexpr int DM = 4096, NTOK = 18432, NPR = 16384, NA = 10240, NB = 6144, N1 = 16640;
constexpr size_t BLOB = 73728;
constexpr size_t OFF_H = 0, OFF_PREPG = 29360128ull, OFF_BT1 = 285212672ull, OFF_MIXED = OFF_PREPG, OFF_BT2 = OFF_MIXED + 150994944ull,
    OFF_PA = OFF_BT1 + 136314880ull, OFF_PB = OFF_PA + (size_t)NTOK * NA * 2, OFF_ORAW0 = OFF_PB + (size_t)NTOK * NB * 2, OFF_ROWSS = OFF_ORAW0 + 9216ull * 4096, WS_END = OFF_ROWSS + 73728;
static_assert(OFF_PREPG + 4608ull * BLOB == OFF_BT1 + 10240ull * 8192, "overlay must end where the protected Bt1 rows start");
constexpr size_t DO_PREPM = 0, DO_NUM = 2304ull * BLOB, DO_ORAW1 = DO_NUM + (size_t)NTOK * 2048 * 2, DO_GATES = DO_ORAW1 + 9216ull * 4096, DO_EGL = DO_GATES + (size_t)NTOK * 64 * 4,
    DO_MB = DO_EGL + 18432, DO_MDMAX = DO_MB + 589824, DO_MRS = DO_MDMAX + 589824, DO_KN = DO_MRS + 589824, DO_NCS = DO_KN + 1179648, DO_MCS = DO_NCS + 1179648,
    DO_TABK = DO_MCS + 9216, DO_TABD = DO_TABK + 18944, DO_END = DO_TABD + 1536;
static_assert(DO_END <= 301989888ull, "d_out scratch must fit in the y region");
constexpr int NKEPT = 4344, NDEF = 336;
constexpr size_t O_Y = 0, O_CONV_P = 75497472ull, O_GDN_P = O_CONV_P + 36864, O_C_P = O_GDN_P + 524288, O_N_P = O_C_P + 524288, O_M_P = O_N_P + 2048,
    O_CONV_S = O_M_P + 16, O_GDN_S = O_CONV_S + 589824, O_C_S = O_GDN_S + 8388608, O_N_S = O_C_S + 8388608, O_M_S = O_N_S + 32768;
constexpr int LDS_BYTES = 155648;

struct Params {
    const float *xp, *xs, *cache, *sg, *sc, *sn, *sm, *norm_g, *w_in, *conv_w, *a_log, *dt_bias, *gdn_nw, *b_i, *b_f, *ml_nw, *w_out, *final_g;
    float* out; unsigned char* ws; int ph_lo, ph_hi, mode3, pad_;
};

DI int gidx(int cgi, int hd) { return cgi < 256 ? (((cgi >> 7) * 16 + hd) * 128 + (cgi & 127)) : (4096 + (cgi - 256) * 16 + hd); }
DI int midx(int cgi, int hd) { return cgi < 256 ? (((cgi >> 7) * 8 + hd) * 128 + (cgi & 127)) : (2048 + (cgi - 256) * 8 + hd); }
DI bf16_t* oraw_blk(const Params& p, int gi) { return gi < 2304 ? (bf16_t*)(p.ws + OFF_ORAW0) + (size_t)gi * 8192 : (bf16_t*)((unsigned char*)p.out + DO_ORAW1) + (size_t)(gi - 2304) * 8192; }
DI float bf2f(bf16_t b) { return __uint_as_float(((unsigned)b) << 16); }
DI unsigned pk2(float a, float b) { f32x2_t v = {a, b}; bf16x2_t r = __builtin_convertvector(v, bf16x2_t); return __builtin_bit_cast(unsigned, r); }
DI bf16_t f2bf(float a) { return (bf16_t)(pk2(a, 0.f) & 0xffffu); }
DI bf16x8 pack8(float a0, float a1, float a2, float a3, float a4, float a5, float a6, float a7) {
    u32x4 p; p[0] = pk2(a0, a1); p[1] = pk2(a2, a3); p[2] = pk2(a4, a5); p[3] = pk2(a6, a7); return __builtin_bit_cast(bf16x8, p); }
DI bf16x8 pack_step(const f32x16& x, int s) { return pack8(x[8 * s], x[8 * s + 1], x[8 * s + 2], x[8 * s + 3], x[8 * s + 4], x[8 * s + 5], x[8 * s + 6], x[8 * s + 7]); }
DI int crow(int reg, int h) { return (reg & 3) + 8 * (reg >> 2) + 4 * h; }
DI float wave_sum(float v) { for (int o = 32; o >= 1; o >>= 1) v += __shfl_xor(v, o); return v; }
DI bf16x8 ld8f(const float* p) { const f32x4 a = *(const f32x4*)p, b = *(const f32x4*)(p + 4); return pack8(a[0], a[1], a[2], a[3], b[0], b[1], b[2], b[3]); }
DI float silu_f(float y) { return y * __builtin_amdgcn_rcpf(1.f + __expf(-y)); }
DI float sigm_f(float y) { return __builtin_amdgcn_rcpf(1.f + __expf(-y)); }
DI float softplus_f(float x) { return fmaxf(x, 0.f) + log1pf(expf(-fabsf(x))); }

DI int emap1(int n) {
    if (n < 6144) return n;
    if (n < 10240) return 8224 + (n - 6144);
    if (n < 12288) return 6144 + (n - 10240);
    if (n < 16384) return 12320 + (n - 12288);
    if (n < 16416) return 8192 + (n - 16384);
    if (n < 16432) return n;
    return -1;
}
DI void transpose_tiles(const Params& p, unsigned char* smem, int tid, bool second) {
    float* tl = (float*)smem;
    bf16_t* dst = (bf16_t*)(p.ws + (second ? OFF_BT2 : OFF_BT1));
    const int NT = second ? 64 * 16 : (N1 / 64) * 16;
    for (int tt = blockIdx.x; tt < NT; tt += gridDim.x) {
        const int n0 = (tt >> 4) * 64, d0 = (tt & 15) * 256;
        const int nn = tid & 63; const int e = second ? (n0 + nn) : emap1(n0 + nn);
        const float* src = second ? p.w_out : p.w_in; const int ld = second ? 4096 : 16432;
        float v[32];
#pragma unroll
        for (int i = 0; i < 32; ++i) { const int dd = (tid >> 6) + 8 * i; v[i] = e >= 0 ? src[(size_t)(d0 + dd) * ld + e] : 0.f; }
#pragma unroll
        for (int i = 0; i < 32; ++i) { const int dd = (tid >> 6) + 8 * i; tl[dd * 65 + nn] = v[i]; }
        __syncthreads();
        const int nn2 = tid >> 3;
#pragma unroll
        for (int j = 0; j < 4; ++j) { const int ds = (tid & 7) * 8 + 64 * j;
            const bf16x8 o = pack8(tl[(ds + 0) * 65 + nn2], tl[(ds + 1) * 65 + nn2], tl[(ds + 2) * 65 + nn2], tl[(ds + 3) * 65 + nn2], tl[(ds + 4) * 65 + nn2], tl[(ds + 5) * 65 + nn2], tl[(ds + 6) * 65 + nn2], tl[(ds + 7) * 65 + nn2]);
            *(bf16x8*)(dst + (size_t)(n0 + nn2) * DM + d0 + ds) = o; }
        __syncthreads();
    }
}
DI void phase0(const Params& p, unsigned char* smem) {
    int tid_ = threadIdx.x; asm volatile("" : "+v"(tid_));
    const int tid = tid_, lane = tid & 63, wid = tid >> 6;
    const int gw = blockIdx.x * 8 + wid, nw = gridDim.x * 8;
    bf16_t* hb = (bf16_t*)(p.ws + OFF_H);
    for (int row = gw; row < NTOK; row += nw) {
        const float* xr = row < NPR ? p.xp + (size_t)row * DM : p.xs + (size_t)(row - NPR) * DM;
        f32x4 v[16]; float ss = 0.f;
#pragma unroll
        for (int i = 0; i < 16; ++i) { v[i] = *(const f32x4*)(xr + (lane + 64 * i) * 4); ss += v[i][0] * v[i][0] + v[i][1] * v[i][1] + v[i][2] * v[i][2] + v[i][3] * v[i][3]; }
        ss = wave_sum(ss);
        const float rs = rsqrtf(ss * (1.f / DM) + 1e-6f);
#pragma unroll
        for (int i = 0; i < 16; ++i) { const f32x4 g = *(const f32x4*)(p.norm_g + (lane + 64 * i) * 4);
            uint2 o; o.x = pk2(v[i][0] * rs * g[0], v[i][1] * rs * g[1]); o.y = pk2(v[i][2] * rs * g[2], v[i][3] * rs * g[3]);
            *(uint2*)(hb + (size_t)row * DM + (lane + 64 * i) * 4) = o; }
    }
    float* rowss = (float*)(p.ws + OFF_ROWSS);
    for (int i = blockIdx.x * 512 + tid; i < NTOK; i += gridDim.x * 512) rowss[i] = 0.f;
    transpose_tiles(p, smem, tid, false);
    if (blockIdx.x == 0 && wid == 0) {
        unsigned* tk = (unsigned*)((unsigned char*)p.out + DO_TABK); unsigned* td = (unsigned*)((unsigned char*)p.out + DO_TABD);
        int nk = 0, nd = 0;
        for (int base = 0; base < 4680; base += 64) { const int wg = base + lane; const bool valid = wg < 4680;
            const int gid = wg / 520, rem = wg - gid * 520, pm = gid * 8 + (rem & 7), pn = rem >> 3;
            const bool def = valid && pn >= 40 && pn < 64 && pm < 14, keep = valid && !def;
            const unsigned long long mk = __ballot(keep), md = __ballot(def); const unsigned long long below = (1ull << lane) - 1ull;
            if (keep) tk[nk + __popcll(mk & below)] = (unsigned)(pm << 8 | pn);
            if (def) td[nd + __popcll(md & below)] = (unsigned)(pm << 8 | pn);
            nk += __popcll(mk); nd += __popcll(md); }
    }
}

struct Epi1 {
    static constexpr bool PERM = true, AFTER_DRAIN = false;
    bf16_t* pa; bf16_t* pb; float* gates;
    DI void operator()(const f32x4 (&acc)[2][2][4][2], const pg8::Unit& u, int wr, int wc, int fr, int fq) const {
        const int row0 = u.pm * 256 + wr * 64 + fr;
        if (u.pn < 64) {
            bf16_t* base; int ldc, colt;
            if (u.pn < 40) { base = pa; ldc = NA; colt = u.pn * 256; } else { base = pb; ldc = NB; colt = (u.pn - 40) * 256; }
            const int col0 = colt + wc * 32 + 8 * fq;
#pragma unroll
            for (int ai = 0; ai < 2; ++ai)
#pragma unroll
                for (int m = 0; m < 4; ++m) { bf16_t* rowp = base + (size_t)(row0 + ai * 128 + m * 16) * ldc + col0;
#pragma unroll
                    for (int bj = 0; bj < 2; ++bj) { const f32x4 v0 = acc[ai][bj][m][0], v1 = acc[ai][bj][m][1];
                        u32x4 w; w[0] = pk2(v0[0], v0[1]); w[1] = pk2(v0[2], v0[3]); w[2] = pk2(v1[0], v1[1]); w[3] = pk2(v1[2], v1[3]);
                        *(u32x4*)(rowp + bj * 128) = w; } }
        } else if (wc < 2) {
#pragma unroll
            for (int ai = 0; ai < 2; ++ai)
#pragma unroll
                for (int m = 0; m < 4; ++m) { float* rowp = gates + (size_t)(row0 + ai * 128 + m * 16) * 64 + wc * 32 + 8 * fq;
                    *(f32x4*)rowp = acc[ai][0][m][0]; *(f32x4*)(rowp + 4) = acc[ai][0][m][1]; }
        }
    }
};
struct Epi2 {
    static constexpr bool PERM = false, AFTER_DRAIN = false;
    const float* xp; const float* xs; float* y; float* rowss;
    DI void operator()(const f32x4 (&acc)[2][2][4][2], const pg8::Unit& u, int wr, int wc, int fr, int fq) const {
        const int row0 = u.pm * 256 + wr * 64 + fr, col0 = u.pn * 256 + wc * 32 + 4 * fq;
#pragma unroll
        for (int ai = 0; ai < 2; ++ai)
#pragma unroll
            for (int m = 0; m < 4; ++m) { const int row = row0 + ai * 128 + m * 16;
                const float* xr = (row < NPR ? xp + (size_t)row * DM : xs + (size_t)(row - NPR) * DM) + col0; float* yr = y + (size_t)row * DM + col0; float ssq = 0.f;
#pragma unroll
                for (int bj = 0; bj < 2; ++bj)
#pragma unroll
                    for (int n = 0; n < 2; ++n) { const f32x4 v = acc[ai][bj][m][n] + *(const f32x4*)(xr + bj * 128 + n * 16); *(f32x4*)(yr + bj * 128 + n * 16) = v;
                        ssq += v[0] * v[0] + v[1] * v[1] + v[2] * v[2] + v[3] * v[3]; }
                ssq += __shfl_xor(ssq, 16); ssq += __shfl_xor(ssq, 32);
                if (fq == 0) atomicAdd(rowss + row, ssq); }
    }
};

template <class F> DI void emit_frags(int tid, unsigned char* dst, int MT, int KS, F elem, int nthr = 512) {
    for (int idx = tid; idx < MT * KS * 64; idx += nthr) {
        const int f = idx >> 6, l = idx & 63, mt = f / KS, ks = f - mt * KS, r = l & 31, h = l >> 5;
        const int row = mt * 32 + r, cb = (ks >> 1) * 32 + (ks & 1) * 16 + 4 * h;
        const bf16x8 o = pack8(elem(row, cb), elem(row, cb + 1), elem(row, cb + 2), elem(row, cb + 3), elem(row, cb + 8), elem(row, cb + 9), elem(row, cb + 10), elem(row, cb + 11));
        *(bf16x8*)(dst + (size_t)idx * 16) = o;
    }
}

struct PreG { u32x4 raw[11]; f32x4 w0[4], w1[4]; float gbv, gav; };
DI void gdn_issue(const Params& p, int cgi, int hd, int tid, PreG& pre) {
    const int row0 = cgi * 64; const bool sample = cgi >= 256; const bool first = sample || ((cgi & 127) == 0);
    const bf16_t* pa = (const bf16_t*)(p.ws + OFF_PA); const float* gates = (const float*)((unsigned char*)p.out + DO_GATES);
    if (tid < 384) {
        const int which = tid >> 7, cgp = (tid >> 3) & 15, trun = tid & 7;
        const int cc0 = which * 2048 + hd * 128 + cgp * 8;
#pragma unroll
        for (int j = 0; j < 4; ++j) { pre.w0[j] = *(const f32x4*)(p.conv_w + j * 6144 + cc0); pre.w1[j] = *(const f32x4*)(p.conv_w + j * 6144 + cc0 + 4); }
#pragma unroll
        for (int i = 0; i < 11; ++i) { const int tt = trun * 8 - 3 + i;
            if (tt >= 0 || !first) pre.raw[i] = *(const u32x4*)(pa + (size_t)(row0 + tt) * NA + cc0);
            else if (sample) { const float* cp = p.cache + ((size_t)(cgi - 256) * 3 + (3 + tt)) * 6144 + cc0; const f32x4 a = *(const f32x4*)cp, b = *(const f32x4*)(cp + 4);
                pre.raw[i][0] = pk2(a[0], a[1]); pre.raw[i][1] = pk2(a[2], a[3]); pre.raw[i][2] = pk2(b[0], b[1]); pre.raw[i][3] = pk2(b[2], b[3]); }
            else { pre.raw[i][0] = 0u; pre.raw[i][1] = 0u; pre.raw[i][2] = 0u; pre.raw[i][3] = 0u; } }
    }
    if (tid >= 384 && tid < 448) { pre.gbv = gates[(size_t)(row0 + tid - 384) * 64 + hd]; pre.gav = gates[(size_t)(row0 + tid - 384) * 64 + 16 + hd]; }
}
DI void prep_gdn(const Params& p, unsigned char* smem, int cgi, int hd, PreG& pre, int ncgi, int nhd, bool has_next) {
    int tid_ = threadIdx.x; asm volatile("" : "+v"(tid_));
    const int tid = tid_, lane = tid & 63, wid = tid >> 6, r = lane & 31, h = lane >> 5;
    float* qf = (float*)smem; float* kf = qf + 64 * 132; float* vf = kf + 64 * 132; float* am = vf + 64 * 132; float* qk = am + 64 * 68; float* tm = qk + 64 * 68; float* sc = tm + 64 * 68;
    float* Gs = sc; float* betas = sc + 64; float* eGs = sc + 128; float* decs = sc + 192;
    const int row0 = cgi * 64; const bool sample = cgi >= 256; const bool first = sample || ((cgi & 127) == 0);
    const bf16_t* pa = (const bf16_t*)(p.ws + OFF_PA); const float* gates = (const float*)((unsigned char*)p.out + DO_GATES);
    unsigned char* blob = p.ws + OFF_PREPG + (size_t)gidx(cgi, hd) * BLOB;
    if (tid < 384) {
        const int which = tid >> 7, cgp = (tid >> 3) & 15, trun = tid & 7;
        float* dstm = which == 0 ? qf : which == 1 ? kf : vf;
#pragma unroll
        for (int o = 0; o < 8; ++o) { f32x4 y0, y1;
#pragma unroll
            for (int c = 0; c < 8; ++c) { float acc = 0.f;
#pragma unroll
                for (int j = 0; j < 4; ++j) { const unsigned wd = pre.raw[o + j][c >> 1]; const float xv = (c & 1) ? __uint_as_float(wd & 0xffff0000u) : __uint_as_float(wd << 16);
                    acc += xv * (c < 4 ? pre.w0[j][c & 3] : pre.w1[j][c & 3]); }
                if (c < 4) y0[c & 3] = silu_f(acc); else y1[c & 3] = silu_f(acc); }
            *(f32x4*)(dstm + (trun * 8 + o) * 132 + cgp * 8) = y0; *(f32x4*)(dstm + (trun * 8 + o) * 132 + cgp * 8 + 4) = y1; }
    }
    const float gbv = pre.gbv, gav = pre.gav;
    if (has_next) gdn_issue(p, ncgi, nhd, tid, pre);
    for (int idx = tid; idx < 64 * 68; idx += 512) tm[idx] = 0.f;
    if (tid >= 384 && tid < 448) { const int tg = tid - 384;
        const float beta = 1.f / (1.f + expf(-gbv));
        const float g = -expf(p.a_log[hd]) * softplus_f(gav + p.dt_bias[hd]);
        float G = g;
#pragma unroll
        for (int o = 1; o < 64; o <<= 1) { const float t2 = __shfl_up(G, o); if (lane >= o) G += t2; }
        const float GL = __shfl(G, 63);
        Gs[tg] = G; betas[tg] = beta; eGs[tg] = expf(G); decs[tg] = expf(GL - G);
        if (tg == 63) ((float*)((unsigned char*)p.out + DO_EGL))[cgi * 16 + hd] = expf(G);
    }
    __syncthreads();
    {
        const int t = tid >> 3, part = tid & 7; float* qp = qf + t * 132 + part * 16; float* kp = kf + t * 132 + part * 16;
        f32x4 qv[4], kv[4]; float sq = 0.f, sk = 0.f;
#pragma unroll
        for (int i = 0; i < 4; ++i) { qv[i] = *(const f32x4*)(qp + 4 * i); kv[i] = *(const f32x4*)(kp + 4 * i);
            sq += qv[i][0] * qv[i][0] + qv[i][1] * qv[i][1] + qv[i][2] * qv[i][2] + qv[i][3] * qv[i][3]; sk += kv[i][0] * kv[i][0] + kv[i][1] * kv[i][1] + kv[i][2] * kv[i][2] + kv[i][3] * kv[i][3]; }
        qk[tid] = sq; qk[512 + tid] = sk;
        __syncthreads();
        const f32x4 a0 = *(const f32x4*)(qk + t * 8), a1 = *(const f32x4*)(qk + t * 8 + 4), b0 = *(const f32x4*)(qk + 512 + t * 8), b1 = *(const f32x4*)(qk + 512 + t * 8 + 4);
        const float s1 = rsqrtf(a0[0] + a0[1] + a0[2] + a0[3] + a1[0] + a1[1] + a1[2] + a1[3] + 1e-6f) * 0.08838834764831845f;
        const float s2 = rsqrtf(b0[0] + b0[1] + b0[2] + b0[3] + b1[0] + b1[1] + b1[2] + b1[3] + 1e-6f);
#pragma unroll
        for (int i = 0; i < 4; ++i) { *(f32x4*)(qp + 4 * i) = qv[i] * s1; *(f32x4*)(kp + 4 * i) = kv[i] * s2; }
    }
    __syncthreads();
    { const int mat = wid >> 2, ti = (wid >> 1) & 1, tj = wid & 1; float* dstm = mat ? qk : am;
      if (ti == 0 && tj == 1) {
#pragma unroll
          for (int i = 0; i < 16; ++i) dstm[crow(i, h) * 68 + 32 + r] = 0.f;
      } else {
          const float* A = mat ? qf : kf; f32x16 acc;
#pragma unroll
          for (int i = 0; i < 16; ++i) acc[i] = 0.f;
#pragma unroll
          for (int ks = 0; ks < 8; ++ks) acc = MFMA32(ld8f(A + (ti * 32 + r) * 132 + ks * 16 + h * 8), ld8f(kf + (tj * 32 + r) * 132 + ks * 16 + h * 8), acc);
#pragma unroll
          for (int i = 0; i < 16; ++i) { const int t = ti * 32 + crow(i, h), s = tj * 32 + r;
              const bool keep = mat ? (s <= t) : (s < t); const float d = keep ? __expf(Gs[t] - Gs[s]) : 0.f;
              dstm[t * 68 + s] = mat ? acc[i] * d : betas[t] * acc[i] * d; }
      } }
    __syncthreads();
    if (tid >= 64) {
        emit_frags(tid - 64, blob + 32768, 2, 4, [&](int row, int col) { return qk[row * 68 + col]; }, 448);
        emit_frags(tid - 64, blob + 16384, 2, 8, [&](int row, int col) { return eGs[row] * qf[row * 132 + col]; }, 448);
        emit_frags(tid - 64, blob + 40960, 4, 4, [&](int row, int col) { return kf[col * 132 + row] * decs[col]; }, 448);
    }
    if (tid < 64) {
        const int b0 = (tid >> 4) * 16, col = tid & 15; float a[120], x[16];
#pragma unroll
        for (int i = 1; i < 16; ++i)
#pragma unroll
            for (int s2 = 0; s2 < i; ++s2) a[i * (i - 1) / 2 + s2] = am[(b0 + i) * 68 + b0 + s2];
#pragma unroll
        for (int i = 0; i < 16; ++i) { float v = (i == col) ? 1.f : 0.f;
#pragma unroll
            for (int s2 = 0; s2 < i; ++s2) v -= a[i * (i - 1) / 2 + s2] * x[s2];
            x[i] = v; tm[(b0 + i) * 68 + b0 + col] = v; }
        asm volatile("s_waitcnt lgkmcnt(0)" ::: "memory");
        const int r16 = r & 15;
#pragma unroll
        for (int B = 0; B < 2; ++B) {
            const int c0 = 32 * B; f32x16 mm, tt;
#pragma unroll
            for (int i = 0; i < 16; ++i) { mm[i] = 0.f; tt[i] = 0.f; }
            float bv[8];
#pragma unroll
            for (int j = 0; j < 8; ++j) bv[j] = tm[(c0 + 8 * h + j) * 68 + c0 + r16];
            mm = MFMA32(ld8f(am + (c0 + 16 + r16) * 68 + c0 + 8 * h), pack8(bv[0], bv[1], bv[2], bv[3], bv[4], bv[5], bv[6], bv[7]), mm);
            const float* tp = tm + (c0 + 16 + r16) * 68 + c0 + 16 + 4 * h; const f32x4 lo = *(const f32x4*)tp, hi = *(const f32x4*)(tp + 8);
            tt = MFMA32(pack8(lo[0], lo[1], lo[2], lo[3], hi[0], hi[1], hi[2], hi[3]), pack_step(mm, 0), tt);
#pragma unroll
            for (int i = 0; i < 8; ++i) if (r < 16) tm[(c0 + 16 + crow(i, h)) * 68 + c0 + r] = -tt[i];
        }
        asm volatile("s_waitcnt lgkmcnt(0)" ::: "memory");
    }
    if (wid == 0) {
        f32x16 m1;
#pragma unroll
        for (int i = 0; i < 16; ++i) m1[i] = 0.f;
#pragma unroll
        for (int ks = 0; ks < 2; ++ks) { float bv[8];
#pragma unroll
            for (int j = 0; j < 8; ++j) bv[j] = tm[(ks * 16 + 8 * h + j) * 68 + r];
            m1 = MFMA32(ld8f(am + (32 + r) * 68 + ks * 16 + 8 * h), pack8(bv[0], bv[1], bv[2], bv[3], bv[4], bv[5], bv[6], bv[7]), m1); }
        f32x16 t21;
#pragma unroll
        for (int i = 0; i < 16; ++i) t21[i] = 0.f;
#pragma unroll
        for (int s2 = 0; s2 < 2; ++s2) { const float* tp = tm + (32 + r) * 68 + 32 + 16 * s2 + 4 * h; const f32x4 lo = *(const f32x4*)tp, hi = *(const f32x4*)(tp + 8);
            t21 = MFMA32(pack8(lo[0], lo[1], lo[2], lo[3], hi[0], hi[1], hi[2], hi[3]), pack_step(m1, s2), t21); }
#pragma unroll
        for (int i = 0; i < 16; ++i) tm[(32 + crow(i, h)) * 68 + r] = -t21[i];
    }
    __syncthreads();
    { const int nt = wid & 3, mat = wid >> 2; const float* src = mat ? vf : kf;
      f32x16 acc0, acc1;
#pragma unroll
      for (int i = 0; i < 16; ++i) { acc0[i] = 0.f; acc1[i] = 0.f; }
#pragma unroll
      for (int ks = 0; ks < 4; ++ks) { float bv[8];
#pragma unroll
          for (int j = 0; j < 8; ++j) { const int s = ks * 16 + 8 * h + j; bv[j] = src[s * 132 + nt * 32 + r] * (mat ? betas[s] : betas[s] * eGs[s]); }
          const bf16x8 b = pack8(bv[0], bv[1], bv[2], bv[3], bv[4], bv[5], bv[6], bv[7]);
          const bf16x8 t0 = ld8f(tm + r * 68 + ks * 16 + 8 * h), t1 = ld8f(tm + (32 + r) * 68 + ks * 16 + 8 * h);
          if (mat) { acc0 = MFMA32(t0, b, acc0); acc1 = MFMA32(t1, b, acc1); }
          else { acc0 = MFMA32(b, t0, acc0); acc1 = MFMA32(b, t1, acc1); } }
      if (mat) {
          unsigned char* d0 = blob + 57344 + ((size_t)((0 * 4 + nt) * 64 + lane)) * 32; unsigned char* d1 = blob + 57344 + ((size_t)((1 * 4 + nt) * 64 + lane)) * 32;
          *(bf16x8*)d0 = pack_step(acc0, 0); *(bf16x8*)(d0 + 16) = pack_step(acc0, 1);
          *(bf16x8*)d1 = pack_step(acc1, 0); *(bf16x8*)(d1 + 16) = pack_step(acc1, 1);
      } else {
#pragma unroll
          for (int i = 0; i < 16; ++i) { acc0[i] = -acc0[i]; acc1[i] = -acc1[i]; }
#pragma unroll
          for (int s2 = 0; s2 < 2; ++s2) {
              *(bf16x8*)(blob + ((size_t)((0 * 8 + 2 * nt + s2) * 64 + lane)) * 16) = pack_step(acc0, s2);
              *(bf16x8*)(blob + ((size_t)((1 * 8 + 2 * nt + s2) * 64 + lane)) * 16) = pack_step(acc1, s2); }
      } }
    __syncthreads();
}

struct PreM { u32x4 qr[2], kr[2], vr[4]; float mi, mf; };
DI void ml_issue(const Params& p, int cgi, int hd, int tid, PreM& pre) {
    const int row0 = cgi * 64; const bf16_t* pa = (const bf16_t*)(p.ws + OFF_PA); const float* gates = (const float*)((unsigned char*)p.out + DO_GATES);
#pragma unroll
    for (int it = 0; it < 2; ++it) { const int idx = tid + 512 * it, t = idx >> 4, cgp = idx & 15;
        pre.qr[it] = *(const u32x4*)(pa + (size_t)(row0 + t) * NA + 6144 + hd * 128 + cgp * 8); pre.kr[it] = *(const u32x4*)(pa + (size_t)(row0 + t) * NA + 7168 + hd * 128 + cgp * 8); }
#pragma unroll
    for (int it = 0; it < 4; ++it) { const int idx = tid + 512 * it, t = idx >> 5, cgp = idx & 31; pre.vr[it] = *(const u32x4*)(pa + (size_t)(row0 + t) * NA + 8192 + hd * 256 + cgp * 8); }
    if (tid < 64) { pre.mi = gates[(size_t)(row0 + tid) * 64 + 32 + hd]; pre.mf = gates[(size_t)(row0 + tid) * 64 + 40 + hd]; }
}
DI void prep_ml(const Params& p, unsigned char* smem, int cgi, int hd, PreM& pre, int ncgi, int nhd, bool has_next) {
    int tid_ = threadIdx.x; asm volatile("" : "+v"(tid_));
    const int tid = tid_, lane = tid & 63, wid = tid >> 6, r = lane & 31, h = lane >> 5;
    float* qf = (float*)smem; float* kf = qf + 64 * 132; bf16_t* vb = (bf16_t*)(smem + 67584); float* pm = (float*)(smem + 101376); float* sc = (float*)(smem + 153600);
    float* as_ = sc; float* pms = sc + 64; float* wend = sc + 128;
    const int row0 = cgi * 64; const bf16_t* pa = (const bf16_t*)(p.ws + OFF_PA); const float* gates = (const float*)((unsigned char*)p.out + DO_GATES);
    unsigned char* blob = (unsigned char*)p.out + DO_PREPM + (size_t)midx(cgi, hd) * BLOB;
#pragma unroll
    for (int it = 0; it < 2; ++it) { const int idx = tid + 512 * it, t = idx >> 4, cgp = idx & 15;
        const u32x4 qr = pre.qr[it], kr = pre.kr[it];
        f32x4 a, b, c2, d; const float ks = 0.08838834764831845f;
        a[0] = __uint_as_float(qr[0] << 16); a[1] = __uint_as_float(qr[0] & 0xffff0000u); a[2] = __uint_as_float(qr[1] << 16); a[3] = __uint_as_float(qr[1] & 0xffff0000u);
        b[0] = __uint_as_float(qr[2] << 16); b[1] = __uint_as_float(qr[2] & 0xffff0000u); b[2] = __uint_as_float(qr[3] << 16); b[3] = __uint_as_float(qr[3] & 0xffff0000u);
        c2[0] = ks * __uint_as_float(kr[0] << 16); c2[1] = ks * __uint_as_float(kr[0] & 0xffff0000u); c2[2] = ks * __uint_as_float(kr[1] << 16); c2[3] = ks * __uint_as_float(kr[1] & 0xffff0000u);
        d[0] = ks * __uint_as_float(kr[2] << 16); d[1] = ks * __uint_as_float(kr[2] & 0xffff0000u); d[2] = ks * __uint_as_float(kr[3] << 16); d[3] = ks * __uint_as_float(kr[3] & 0xffff0000u);
        *(f32x4*)(qf + t * 132 + cgp * 8) = a; *(f32x4*)(qf + t * 132 + cgp * 8 + 4) = b; *(f32x4*)(kf + t * 132 + cgp * 8) = c2; *(f32x4*)(kf + t * 132 + cgp * 8 + 4) = d; }
#pragma unroll
    for (int it = 0; it < 4; ++it) { const int idx = tid + 512 * it, t = idx >> 5, cgp = idx & 31;
        *(u32x4*)(vb + t * 264 + cgp * 8) = pre.vr[it]; }
    const float mi = pre.mi, mf = pre.mf;
    if (has_next) ml_issue(p, ncgi, nhd, tid, pre);
    if (tid < 64) {
        const float logi = mi + p.b_i[hd]; const float logf = -softplus_f(-(mf + p.b_f[hd]));
        float b = logf;
#pragma unroll
        for (int o = 1; o < 64; o <<= 1) { const float t2 = __shfl_up(b, o); if (lane >= o) b += t2; }
        const float a = logi - b; float px = a;
#pragma unroll
        for (int o = 1; o < 64; o <<= 1) { const float t2 = __shfl_up(px, o); if (lane >= o) px = fmaxf(px, t2); }
        const float p63 = __shfl(px, 63);
        as_[tid] = a; pms[tid] = px; wend[tid] = expf(a - p63);
        ((float*)((unsigned char*)p.out + DO_MB))[(size_t)(row0 + tid) * 8 + hd] = b; ((float*)((unsigned char*)p.out + DO_MDMAX))[(size_t)(row0 + tid) * 8 + hd] = b + px;
    }
    __syncthreads();
    if (wid < 4) {
        const int ti = wid >> 1, tj = wid & 1;
        if (ti == 0 && tj == 1) {
#pragma unroll
            for (int i = 0; i < 16; ++i) pm[crow(i, h) * 68 + 32 + r] = 0.f;
        } else { f32x16 acc;
#pragma unroll
            for (int i = 0; i < 16; ++i) acc[i] = 0.f;
#pragma unroll
            for (int ks = 0; ks < 8; ++ks) acc = MFMA32(ld8f(qf + (ti * 32 + r) * 132 + ks * 16 + h * 8), ld8f(kf + (tj * 32 + r) * 132 + ks * 16 + h * 8), acc);
#pragma unroll
            for (int i = 0; i < 16; ++i) { const int t = ti * 32 + crow(i, h), s = tj * 32 + r; pm[t * 68 + s] = (s <= t) ? acc[i] * __expf(as_[s] - pms[t]) : 0.f; }
        }
    } else if (tid < 256 + 128) { const int k = tid - 256; float a = 0.f;
        for (int s = 0; s < 64; ++s) a += wend[s] * kf[s * 132 + k];
        ((float*)((unsigned char*)p.out + DO_KN))[((size_t)cgi * 8 + hd) * 128 + k] = a; }
    emit_frags(tid, blob, 2, 8, [&](int row, int col) { return qf[row * 132 + col]; });
    emit_frags(tid, blob + 24576, 4, 4, [&](int row, int col) { return kf[col * 132 + row] * wend[col]; });
    for (int idx = tid; idx < 8 * 4 * 64; idx += 512) { const int f = idx >> 6, l = idx & 63, nt = f >> 2, ks = f & 3, c = l & 31, hh = l >> 5;
        const int sb = (ks >> 1) * 32 + (ks & 1) * 16 + 4 * hh; bf16x8 o;
#pragma unroll
        for (int j = 0; j < 8; ++j) o[j] = (short)vb[(sb + 8 * (j >> 2) + (j & 3)) * 264 + nt * 32 + c];
        *(bf16x8*)(blob + 40960 + (size_t)idx * 16) = o; }
    __syncthreads();
    if (tid < 64) { float a = 0.f; for (int s = 0; s < 64; ++s) a += pm[tid * 68 + s]; ((float*)((unsigned char*)p.out + DO_MRS))[(size_t)(row0 + tid) * 8 + hd] = a; }
    emit_frags(tid, blob + 16384, 2, 4, [&](int row, int col) { return pm[row * 68 + col]; });
    __syncthreads();
}

DI void lds_copy_kb(LAS unsigned char* lbuf, const unsigned char* g, int nkb, int wid, int lane) {
    for (int kb = wid; kb < nkb; kb += 8)
        __builtin_amdgcn_global_load_lds((const unsigned*)(g + (size_t)kb * 1024 + lane * 16), (LAS unsigned*)(lbuf + kb * 1024), 16, 0, 0);
}
#define WAIT_ALL_VM() asm volatile("s_waitcnt vmcnt(0)" ::: "memory")
template <int NP> DI void ldp_gdn(u32x4 (&R)[NP], const unsigned char* g, int lw, int lane) {
    const unsigned lo = (unsigned)lane * 16u;
#pragma unroll
    for (int j = 0; j < NP; ++j) { const unsigned char* gj = g + (size_t)((lw * NP + j) * 1024); R[j] = *(const u32x4*)(gj + lo); } }
template <int NP> DI void ldp_ml(u32x4 (&R)[NP], const unsigned char* g, int half, int lw, int lane) {
    const unsigned lo = (unsigned)lane * 16u;
#pragma unroll
    for (int j = 0; j < NP; ++j) { const int kb = lw * NP + j; const unsigned char* gj = g + (size_t)((kb < 40 ? 0 : half * 16384) + kb * 1024); R[j] = *(const u32x4*)(gj + lo); } }
template <int NP> DI void stp(const u32x4 (&R)[NP], LAS unsigned char* l, int lw, int lane) {
#pragma unroll
    for (int j = 0; j < NP; ++j) *(LAS u32x4*)(l + ((lw * NP + j) * 64 + lane) * 16) = R[j]; }

DI void scan_gdn(const Params& p, unsigned char* smem, int seq, int hd) {
    int tid_ = threadIdx.x; asm volatile("" : "+v"(tid_));
    const int tid = tid_, lane = tid & 63, wid = __builtin_amdgcn_readfirstlane(tid >> 6), r = lane & 31, h = lane >> 5, w = wid;
    const int nch = seq < 2 ? 128 : 1, cg0 = seq < 2 ? seq * 128 : 256 + (seq - 2);
    LAS unsigned char* lds = (LAS unsigned char*)smem;
    const unsigned char* blob0 = p.ws + OFF_PREPG + (size_t)gidx(cg0, hd) * BLOB;
    const float* egl = (const float*)((unsigned char*)p.out + DO_EGL);
    const int sbase = (4 * h * 128 + 32 * (w & 3) + r) * 4;
    __syncthreads();
    if (seq >= 2) { lds_copy_kb(lds + BLOB, (const unsigned char*)(p.sg + ((size_t)(seq - 2) * 16 + hd) * 16384), 64, wid, lane); WAIT_ALL_VM(); }
    __syncthreads();
    if (w < 4) {
        f32x16 S[4];
        if (seq >= 2) {
#pragma unroll
            for (int kt = 0; kt < 4; ++kt)
#pragma unroll
                for (int i = 0; i < 16; ++i) S[kt][i] = *(const LAS float*)(lds + BLOB + sbase + (32 * kt + (i & 3) + 8 * (i >> 2)) * 512);
        } else {
#pragma unroll
            for (int kt = 0; kt < 4; ++kt)
#pragma unroll
                for (int i = 0; i < 16; ++i) S[kt][i] = 0.f;
        }
        float eg_next = egl[cg0 * 16 + hd];
        __syncthreads();
        __syncthreads();
        for (int c = 0; c < nch; ++c) {
            const int cur = c & 1; const float eg = eg_next;
            if (c + 1 < nch) eg_next = egl[(cg0 + c + 1) * 16 + hd];
            const LAS unsigned char* buf = lds + cur * BLOB;
            f32x16 U[2], O[2];
#pragma unroll
            for (int mt = 0; mt < 2; ++mt) {
                const LAS bf16x8* up = (const LAS bf16x8*)(buf + 57344 + ((mt * 4 + w) * 64 + lane) * 32);
                const bf16x8 u0 = up[0], u1 = up[1];
#pragma unroll
                for (int i = 0; i < 8; ++i) { U[mt][i] = bf2f((bf16_t)u0[i]); U[mt][8 + i] = bf2f((bf16_t)u1[i]); O[mt][i] = 0.f; O[mt][8 + i] = 0.f; }
            }
#define FRG(off) (*(const LAS bf16x8*)(buf + (off) + lane * 16))
            bf16x8 fcur[6], fnxt[6];
            fcur[0] = FRG(0); fcur[1] = FRG(16384); fcur[2] = FRG(8192); fcur[3] = FRG(24576);
#pragma unroll
            for (int ks = 0; ks < 8; ++ks) {
                if (ks < 7) { fnxt[0] = FRG((ks + 1) * 1024); fnxt[1] = FRG(16384 + (ks + 1) * 1024); fnxt[2] = FRG(8192 + (ks + 1) * 1024); fnxt[3] = FRG(24576 + (ks + 1) * 1024); }
                else { fnxt[0] = FRG(32768); fnxt[1] = FRG(32768 + 4096); fnxt[2] = FRG(40960); fnxt[3] = FRG(40960 + 4096); fnxt[4] = FRG(40960 + 8192); fnxt[5] = FRG(40960 + 12288); }
                const bf16x8 sf = pack_step(S[ks >> 1], ks & 1);
                U[0] = MFMA32(fcur[0], sf, U[0]); O[0] = MFMA32(fcur[1], sf, O[0]); U[1] = MFMA32(fcur[2], sf, U[1]); O[1] = MFMA32(fcur[3], sf, O[1]);
                __builtin_amdgcn_sched_barrier(0);
#pragma unroll
                for (int i = 0; i < 6; ++i) fcur[i] = fnxt[i];
            }
#pragma unroll
            for (int kt = 0; kt < 4; ++kt)
#pragma unroll
                for (int i = 0; i < 16; ++i) S[kt][i] *= eg;
#pragma unroll
            for (int ks = 0; ks < 4; ++ks) {
                if (ks < 3) { fnxt[0] = FRG(32768 + (ks + 1) * 1024); fnxt[1] = FRG(32768 + 4096 + (ks + 1) * 1024);
#pragma unroll
                    for (int kt = 0; kt < 4; ++kt) fnxt[2 + kt] = FRG(40960 + kt * 4096 + (ks + 1) * 1024); }
                const bf16x8 uf = pack_step(U[ks >> 1], ks & 1);
                O[0] = MFMA32(fcur[0], uf, O[0]); O[1] = MFMA32(fcur[1], uf, O[1]);
#pragma unroll
                for (int kt = 0; kt < 4; ++kt) S[kt] = MFMA32(fcur[2 + kt], uf, S[kt]);
                __builtin_amdgcn_sched_barrier(0);
#pragma unroll
                for (int i = 0; i < 6; ++i) fcur[i] = fnxt[i];
            }
#undef FRG
            unsigned long long ob = (unsigned long long)(oraw_blk(p, gidx(cg0 + c, hd)) + (4 * h) * 128 + 32 * w + r);
            asm volatile("" : "+v"(ob));
#pragma unroll
            for (int mt = 0; mt < 2; ++mt)
#pragma unroll
                for (int i = 0; i < 16; ++i) *(GAS bf16_t*)(ob + (size_t)(32 * mt + (i & 3) + 8 * (i >> 2)) * 256) = f2bf(O[mt][i]);
            __syncthreads();
        }
#pragma unroll
        for (int kt = 0; kt < 4; ++kt)
#pragma unroll
            for (int i = 0; i < 16; ++i) *(LAS float*)(lds + sbase + (32 * kt + (i & 3) + 8 * (i >> 2)) * 512) = S[kt][i];
    } else {
        const int lw = w - 4;
        if (nch == 1) {
            u32x4 Ra[18];
            ldp_gdn(Ra, blob0, lw, lane);
            __syncthreads();
            stp(Ra, lds, lw, lane);
            __syncthreads();
            __syncthreads();
        } else {
        u32x4 Ra[18], Rb[18];
        const int last = nch - 1;
#define GBLOB(cc) (blob0 + (size_t)((cc) < last ? (cc) : last) * BLOB)
        ldp_gdn(Ra, blob0, lw, lane);
        __syncthreads();
        stp(Ra, lds, lw, lane);
        ldp_gdn(Rb, GBLOB(1), lw, lane);
        ldp_gdn(Ra, GBLOB(2), lw, lane);
        __syncthreads();
        for (int c = 0; c < nch; c += 2) {
            stp(Rb, lds + BLOB, lw, lane);
            ldp_gdn(Rb, GBLOB(c + 3), lw, lane);
            __syncthreads();
            if (c + 1 < nch) {
                stp(Ra, lds, lw, lane);
                ldp_gdn(Ra, GBLOB(c + 4), lw, lane);
                __syncthreads();
            }
        }
#undef GBLOB
            }
    }
    {   float* dst = p.out + (seq < 2 ? O_GDN_P + ((size_t)seq * 16 + hd) * 16384 : O_GDN_S + ((size_t)(seq - 2) * 16 + hd) * 16384);
        __syncthreads();
        for (int i = tid; i < 4096; i += 512) *(f32x4*)(dst + i * 4) = *(const LAS f32x4*)(lds + i * 16);
        __syncthreads();
    }
}

DI void scan_ml(const Params& p, unsigned char* smem, int seq, int hd, int half) {
    int tid_ = threadIdx.x; asm volatile("" : "+v"(tid_));
    const int tid = tid_, lane = tid & 63, wid = __builtin_amdgcn_readfirstlane(tid >> 6), r = lane & 31, h = lane >> 5, w = wid;
    const int nch = seq < 2 ? 128 : 1, cg0 = seq < 2 ? seq * 128 : 256 + (seq - 2);
    LAS unsigned char* lds = (LAS unsigned char*)smem; float* scr = (float*)(smem + 147456) + wid * 128;
    const unsigned char* blob0 = (const unsigned char*)p.out + DO_PREPM + (size_t)midx(cg0, hd) * BLOB;
    bf16_t* num = (bf16_t*)((unsigned char*)p.out + DO_NUM);
    const float* mbp = (const float*)((unsigned char*)p.out + DO_MB); const float* mdp = (const float*)((unsigned char*)p.out + DO_MDMAX); const float* knp = (const float*)((unsigned char*)p.out + DO_KN);
    float* ncs = (float*)((unsigned char*)p.out + DO_NCS); float* mcs = (float*)((unsigned char*)p.out + DO_MCS);
    const bool nwave = (w == 4) && (half == 0);
    float m = 0.f;
    if (seq >= 2) m = p.sm[(seq - 2) * 8 + hd];
    const int sbase = (4 * h * 128 + 32 * (w & 3) + r) * 4;
    __syncthreads();
    if (seq >= 2) {
        const unsigned char* C0 = (const unsigned char*)(p.sc + ((size_t)(seq - 2) * 8 + hd) * 32768) + half * 512;
        for (int kb = wid; kb < 64; kb += 8)
            __builtin_amdgcn_global_load_lds((const unsigned*)(C0 + (size_t)(2 * kb + (lane >> 5)) * 1024 + (lane & 31) * 16), (LAS unsigned*)(lds + BLOB + kb * 1024), 16, 0, 0);
        WAIT_ALL_VM();
    }
    __syncthreads();
    float bt_n = mbp[((size_t)cg0 * 64 + lane) * 8 + hd], dm_n = mdp[((size_t)cg0 * 64 + lane) * 8 + hd];
    if (w < 4) {
        f32x16 C[4];
        if (seq >= 2) {
#pragma unroll
            for (int kt = 0; kt < 4; ++kt)
#pragma unroll
                for (int i = 0; i < 16; ++i) C[kt][i] = *(const LAS float*)(lds + BLOB + sbase + (32 * kt + (i & 3) + 8 * (i >> 2)) * 512);
        } else {
#pragma unroll
            for (int kt = 0; kt < 4; ++kt)
#pragma unroll
                for (int i = 0; i < 16; ++i) C[kt][i] = 0.f;
        }
        __syncthreads();
        __syncthreads();
        for (int c = 0; c < nch; ++c) {
            const int cur = c & 1; const int cgi = cg0 + c;
            const float bt = bt_n, dm = dm_n;
            if (c + 1 < nch) { bt_n = mbp[((size_t)(cgi + 1) * 64 + lane) * 8 + hd]; dm_n = mdp[((size_t)(cgi + 1) * 64 + lane) * 8 + hd]; }
            const float bL = __shfl(bt, 63), E = __shfl(dm, 63);
            const float inter = bt + m, mtv = fmaxf(inter, dm), wq = __expf(inter - mtv), rr = __expf(dm - mtv);
            const float m_new = __shfl(mtv, 63), wC = __expf(bL + m - m_new), sE = __expf(E - m_new);
            const LAS unsigned char* buf = lds + cur * BLOB;
            scr[lane] = wq; scr[64 + lane] = rr;
#define FRG(off) (*(const LAS bf16x8*)(buf + (off) + lane * 16))
            bf16x8 Vf[4];
#pragma unroll
            for (int ks = 0; ks < 4; ++ks) Vf[ks] = FRG(40960 + (w * 4 + ks) * 1024);
            unsigned long long ob = (unsigned long long)(num + (size_t)midx(cgi, hd) * 16384 + (4 * h) * 256 + half * 128 + 32 * w + r);
            asm volatile("" : "+v"(ob));
            const float* scrh = scr + 4 * h;
            f32x16 QC[2], PV[2];
#pragma unroll
            for (int i = 0; i < 16; ++i) { QC[0][i] = 0.f; QC[1][i] = 0.f; PV[0][i] = 0.f; PV[1][i] = 0.f; }
            bf16x8 fcur[4], fnxt[4];
            fcur[0] = FRG(0); fcur[1] = FRG(8192); fcur[2] = FRG(16384); fcur[3] = FRG(16384 + 4096);
#pragma unroll
            for (int ks = 0; ks < 8; ++ks) {
                if (ks < 7) { fnxt[0] = FRG((ks + 1) * 1024); fnxt[1] = FRG(8192 + (ks + 1) * 1024); if (ks < 3) { fnxt[2] = FRG(16384 + (ks + 1) * 1024); fnxt[3] = FRG(16384 + 4096 + (ks + 1) * 1024); } }
                else { fnxt[0] = FRG(24576); fnxt[1] = FRG(24576 + 4096); fnxt[2] = FRG(24576 + 8192); fnxt[3] = FRG(24576 + 12288); }
                const bf16x8 cf = pack_step(C[ks >> 1], ks & 1);
                QC[0] = MFMA32(fcur[0], cf, QC[0]); QC[1] = MFMA32(fcur[1], cf, QC[1]);
                if (ks < 4) { PV[0] = MFMA32(fcur[2], Vf[ks], PV[0]); PV[1] = MFMA32(fcur[3], Vf[ks], PV[1]); }
                __builtin_amdgcn_sched_barrier(0);
#pragma unroll
                for (int i = 0; i < 4; ++i) fcur[i] = fnxt[i];
            }
#pragma unroll
            for (int kt = 0; kt < 4; ++kt)
#pragma unroll
                for (int i = 0; i < 16; ++i) C[kt][i] *= wC;
#pragma unroll
            for (int ks = 0; ks < 4; ++ks) { float f[8];
#pragma unroll
                for (int j = 0; j < 8; ++j) f[j] = sE * bf2f((bf16_t)Vf[ks][j]);
                Vf[ks] = pack8(f[0], f[1], f[2], f[3], f[4], f[5], f[6], f[7]); }
#pragma unroll
            for (int ks = 0; ks < 4; ++ks) {
                if (ks < 3) {
#pragma unroll
                    for (int kt = 0; kt < 4; ++kt) fnxt[kt] = FRG(24576 + kt * 4096 + (ks + 1) * 1024); }
#pragma unroll
                for (int kt = 0; kt < 4; ++kt) C[kt] = MFMA32(fcur[kt], Vf[ks], C[kt]);
                __builtin_amdgcn_sched_barrier(0);
#pragma unroll
                for (int i = 0; i < 4; ++i) fcur[i] = fnxt[i];
            }
#undef FRG
#pragma unroll
            for (int mt = 0; mt < 2; ++mt)
#pragma unroll
                for (int i = 0; i < 16; ++i) { const int t0 = 32 * mt + (i & 3) + 8 * (i >> 2);
                    *(GAS bf16_t*)(ob + (size_t)t0 * 512) = f2bf(scrh[t0] * QC[mt][i] + scrh[64 + t0] * PV[mt][i]); }
            m = m_new;
            __syncthreads();
        }
#pragma unroll
        for (int kt = 0; kt < 4; ++kt)
#pragma unroll
            for (int i = 0; i < 16; ++i) *(LAS float*)(lds + sbase + (32 * kt + (i & 3) + 8 * (i >> 2)) * 512) = C[kt][i];
    } else {
        const int lw = w - 4;
        float n0 = 0.f, n1 = 0.f, k0_n = 0.f, k1_n = 0.f;
        if (nwave) { if (seq >= 2) { n0 = p.sn[((size_t)(seq - 2) * 8 + hd) * 128 + lane]; n1 = p.sn[((size_t)(seq - 2) * 8 + hd) * 128 + 64 + lane]; }
            k0_n = knp[((size_t)cg0 * 8 + hd) * 128 + lane]; k1_n = knp[((size_t)cg0 * 8 + hd) * 128 + 64 + lane]; }
        auto nstep = [&](int c) {
            const int cgi = cg0 + c;
            const float bt = bt_n, dm = dm_n, k0 = k0_n, k1 = k1_n;
            if (c + 1 < nch) { bt_n = mbp[((size_t)(cgi + 1) * 64 + lane) * 8 + hd]; dm_n = mdp[((size_t)(cgi + 1) * 64 + lane) * 8 + hd];
                k0_n = knp[((size_t)(cgi + 1) * 8 + hd) * 128 + lane]; k1_n = knp[((size_t)(cgi + 1) * 8 + hd) * 128 + 64 + lane]; }
            const float bL = __shfl(bt, 63), E = __shfl(dm, 63);
            const float mtv = fmaxf(bt + m, dm);
            const float m_new = __shfl(mtv, 63), wC = __expf(bL + m - m_new), sE = __expf(E - m_new);
            ncs[((size_t)cgi * 8 + hd) * 128 + lane] = n0; ncs[((size_t)cgi * 8 + hd) * 128 + 64 + lane] = n1;
            if (lane == 0) mcs[cgi * 8 + hd] = m;
            n0 = wC * n0 + sE * k0; n1 = wC * n1 + sE * k1;
            m = m_new;
        };
        if (nch == 1) {
            u32x4 Ra[14];
            ldp_ml(Ra, blob0, half, lw, lane);
            __syncthreads();
            stp(Ra, lds, lw, lane);
            __syncthreads();
            if (nwave) nstep(0);
            __syncthreads();
        } else {
        u32x4 Ra[14], Rb[14];
        const int last = nch - 1;
#define MBLOB(cc) (blob0 + (size_t)((cc) < last ? (cc) : last) * BLOB)
        ldp_ml(Ra, blob0, half, lw, lane);
        __syncthreads();
        stp(Ra, lds, lw, lane);
        ldp_ml(Rb, MBLOB(1), half, lw, lane);
        ldp_ml(Ra, MBLOB(2), half, lw, lane);
        __syncthreads();
        for (int c = 0; c < nch; c += 2) {
            stp(Rb, lds + BLOB, lw, lane);
            ldp_ml(Rb, MBLOB(c + 3), half, lw, lane);
            if (nwave) nstep(c);
            __syncthreads();
            if (c + 1 < nch) {
                stp(Ra, lds, lw, lane);
                ldp_ml(Ra, MBLOB(c + 4), half, lw, lane);
                if (nwave) nstep(c + 1);
                __syncthreads();
            }
        }
        }
#undef MBLOB
        if (nwave) {
            float* dn = p.out + (seq < 2 ? O_N_P + ((size_t)seq * 8 + hd) * 128 : O_N_S + ((size_t)(seq - 2) * 8 + hd) * 128);
            dn[lane] = n0; dn[64 + lane] = n1;
            if (lane == 0) p.out[(seq < 2 ? O_M_P + seq * 8 + hd : O_M_S + (seq - 2) * 8 + hd)] = m;
        }
    }
    {   float* dst = p.out + (seq < 2 ? O_C_P + ((size_t)seq * 8 + hd) * 32768 : O_C_S + ((size_t)(seq - 2) * 8 + hd) * 32768) + half * 128;
        __syncthreads();
        for (int i = tid; i < 4096; i += 512) *(f32x4*)(dst + (i >> 5) * 256 + (i & 31) * 4) = *(const LAS f32x4*)(lds + i * 16);
        __syncthreads();
    }
}

struct TableOrder {
    const unsigned* tab; int n, G, c; bool remap;
    DI bool next(int i, pg8::Unit& u) const {
        const long L = (long)i * G + c; if (L >= n) return false;
        int w = (int)L;
        if (remap) { const int q = n / 8, r = n % 8, xcd = w % 8, off = w / 8; w = (xcd < r ? xcd * (q + 1) : r * (q + 1) + (xcd - r) * q) + off; }
        const unsigned v = tab[w]; u.pm = (int)(v >> 8); u.pn = (int)(v & 255u); return true;
    }
    DI void a_ready(const pg8::Unit&) const {}
    DI void done(const pg8::Unit&) const {}
};
DI void gemm1_units(const Params& p, unsigned char* smem, const unsigned* tab, int n, int G, int c, bool remap) {
    pg8::Gemm g; g.A = (const bf16_t*)(p.ws + OFF_H); g.Bt = (const bf16_t*)(p.ws + OFF_BT1); g.M = NTOK; g.N = N1; g.K = DM;
    TableOrder S; S.tab = tab; S.n = n; S.G = G; S.c = c; S.remap = remap;
    Epi1 E; E.pa = (bf16_t*)(p.ws + OFF_PA); E.pb = (bf16_t*)(p.ws + OFF_PB); E.gates = (float*)((unsigned char*)p.out + DO_GATES);
    pg8::gemm_phase<Epi1, TableOrder, false>((LAS unsigned char*)smem, g, S, E, nullptr);
    __syncthreads();
}
DI void phase1(const Params& p, unsigned char* smem) {
    gemm1_units(p, smem, (const unsigned*)((const unsigned char*)p.out + DO_TABK), NKEPT, (int)gridDim.x, (int)blockIdx.x, true);
}
DI void phase3(const Params& p, unsigned char* smem) {
    const int b = blockIdx.x;
    if (b < 32) { if (p.mode3 & 1) scan_gdn(p, smem, b >> 4, b & 15); }
    else if (b < 64) { if (p.mode3 & 1) { const int i = b - 32; scan_ml(p, smem, i >> 4, (i >> 1) & 7, i & 1); } }
    else {
        if (p.mode3 & 2) {
            const int c = b - 64; int it0 = c, step = (int)gridDim.x - 64, itend = 1024;
            if (gridDim.x == 256) {
                if (c < 144) { step = 144; itend = 576; } else { it0 = 576 + (c - 144); step = 48; } }
#pragma unroll 1
            for (int it = it0; it < itend; it += step) {
                if (it < 512) scan_gdn(p, smem, 2 + (it >> 4), it & 15);
                else { const int i = it - 512; scan_ml(p, smem, 2 + (i >> 4), (i >> 1) & 7, i & 1); }
                __syncthreads();
            }
        }
        __syncthreads();
        if (p.mode3 & 4) gemm1_units(p, smem, (const unsigned*)((const unsigned char*)p.out + DO_TABD), NDEF, (int)gridDim.x - 64, b - 64, false);
    }
}

DI void unpk8(const u32x4 v, float (&f)[8]) {
#pragma unroll
    for (int i = 0; i < 4; ++i) { f[2 * i] = __uint_as_float(v[i] << 16); f[2 * i + 1] = __uint_as_float(v[i] & 0xffff0000u); } }
DI void phase4(const Params& p, unsigned char* smem) {
    int tid_ = threadIdx.x; asm volatile("" : "+v"(tid_));
    const int tid = tid_, lane = tid & 63, wid = tid >> 6;
    const int gw = blockIdx.x * 8 + wid, nw = gridDim.x * 8;
    const bf16_t* num = (const bf16_t*)((const unsigned char*)p.out + DO_NUM);
    const bf16_t* pa = (const bf16_t*)(p.ws + OFF_PA); const bf16_t* pb = (const bf16_t*)(p.ws + OFF_PB);
    const float* mbp = (const float*)((unsigned char*)p.out + DO_MB); const float* mdp = (const float*)((unsigned char*)p.out + DO_MDMAX); const float* mrs = (const float*)((unsigned char*)p.out + DO_MRS);
    const float* ncs = (const float*)((unsigned char*)p.out + DO_NCS); const float* mcs = (const float*)((unsigned char*)p.out + DO_MCS);
    bf16_t* mixed = (bf16_t*)(p.ws + OFF_MIXED);
    const int hm = lane >> 3, sub = lane & 7;
    transpose_tiles(p, smem, tid, true);
    for (int row = gw; row < NTOK; row += nw) {
        const int cgi = row >> 6;
        const bf16_t* orow = oraw_blk(p, gidx(cgi, lane >> 2)) + (row & 63) * 128 + (lane & 3) * 32;
        u32x4 ov[4], zv[4];
#pragma unroll
        for (int i = 0; i < 4; ++i) { ov[i] = *(const u32x4*)(orow + i * 8); zv[i] = *(const u32x4*)(pb + (size_t)row * NB + lane * 32 + i * 8); }
        {
            float ss = 0.f;
#pragma unroll
            for (int i = 0; i < 4; ++i) { float f[8]; unpk8(ov[i], f);
#pragma unroll
                for (int j = 0; j < 8; ++j) ss += f[j] * f[j]; }
            ss += __shfl_xor(ss, 1); ss += __shfl_xor(ss, 2);
            const float rs = rsqrtf(ss * (1.f / 128.f) + 1e-6f);
#pragma unroll
            for (int i = 0; i < 4; ++i) { float f[8], z[8]; unpk8(ov[i], f); unpk8(zv[i], z);
                const f32x4 g0 = *(const f32x4*)(p.gdn_nw + (lane & 3) * 32 + i * 8), g1 = *(const f32x4*)(p.gdn_nw + (lane & 3) * 32 + i * 8 + 4);
                u32x4 o; o[0] = pk2(f[0] * rs * g0[0] * silu_f(z[0]), f[1] * rs * g0[1] * silu_f(z[1])); o[1] = pk2(f[2] * rs * g0[2] * silu_f(z[2]), f[3] * rs * g0[3] * silu_f(z[3]));
                o[2] = pk2(f[4] * rs * g1[0] * silu_f(z[4]), f[5] * rs * g1[1] * silu_f(z[5])); o[3] = pk2(f[6] * rs * g1[2] * silu_f(z[6]), f[7] * rs * g1[3] * silu_f(z[7]));
                *(u32x4*)(mixed + (size_t)row * DM + lane * 32 + i * 8) = o; }
        }
        __builtin_amdgcn_sched_barrier(0);
        u32x4 nv[4], mov[4], mzv[4], qv[2]; f32x4 nn[4];
#pragma unroll
        for (int i = 0; i < 4; ++i) { nv[i] = *(const u32x4*)(num + (size_t)midx(cgi, hm) * 16384 + (row & 63) * 256 + sub * 32 + i * 8); mov[i] = *(const u32x4*)(pb + (size_t)row * NB + 2048 + lane * 32 + i * 8);
            mzv[i] = *(const u32x4*)(pb + (size_t)row * NB + 4096 + lane * 32 + i * 8); nn[i] = *(const f32x4*)(ncs + ((size_t)cgi * 8 + hm) * 128 + sub * 16 + i * 4); }
        qv[0] = *(const u32x4*)(pa + (size_t)row * NA + 6144 + hm * 128 + sub * 16); qv[1] = *(const u32x4*)(pa + (size_t)row * NA + 6144 + hm * 128 + sub * 16 + 8);
        const float mc = mcs[cgi * 8 + hm], bt = mbp[(size_t)row * 8 + hm], dm = mdp[(size_t)row * 8 + hm], rsm = mrs[(size_t)row * 8 + hm];
        {
            float qf8[8], qn = 0.f;
            unpk8(qv[0], qf8); qn += qf8[0] * nn[0][0] + qf8[1] * nn[0][1] + qf8[2] * nn[0][2] + qf8[3] * nn[0][3] + qf8[4] * nn[1][0] + qf8[5] * nn[1][1] + qf8[6] * nn[1][2] + qf8[7] * nn[1][3];
            unpk8(qv[1], qf8); qn += qf8[0] * nn[2][0] + qf8[1] * nn[2][1] + qf8[2] * nn[2][2] + qf8[3] * nn[2][3] + qf8[4] * nn[3][0] + qf8[5] * nn[3][1] + qf8[6] * nn[3][2] + qf8[7] * nn[3][3];
            qn += __shfl_xor(qn, 1); qn += __shfl_xor(qn, 2); qn += __shfl_xor(qn, 4);
            const float inter = bt + mc, mtv = fmaxf(inter, dm), wq = __expf(inter - mtv), rr = __expf(dm - mtv);
            const float den = wq * qn + rr * rsm; const float inv = 1.f / fmaxf(fabsf(den), __expf(-mtv));
            float ss = 0.f;
#pragma unroll
            for (int i = 0; i < 4; ++i) { float f[8]; unpk8(nv[i], f);
#pragma unroll
                for (int j = 0; j < 8; ++j) { const float hv = f[j] * inv; ss += hv * hv; } }
            ss += __shfl_xor(ss, 1); ss += __shfl_xor(ss, 2); ss += __shfl_xor(ss, 4);
            const float rs = rsqrtf(ss * (1.f / 256.f) + 1e-6f) * inv;
#pragma unroll
            for (int i = 0; i < 4; ++i) { float f[8], a[8], z[8]; unpk8(nv[i], f); unpk8(mov[i], a); unpk8(mzv[i], z);
                const f32x4 g0 = *(const f32x4*)(p.ml_nw + sub * 32 + i * 8), g1 = *(const f32x4*)(p.ml_nw + sub * 32 + i * 8 + 4);
                u32x4 o; o[0] = pk2(f[0] * rs * g0[0] * sigm_f(a[0]) * silu_f(z[0]), f[1] * rs * g0[1] * sigm_f(a[1]) * silu_f(z[1]));
                o[1] = pk2(f[2] * rs * g0[2] * sigm_f(a[2]) * silu_f(z[2]), f[3] * rs * g0[3] * sigm_f(a[3]) * silu_f(z[3]));
                o[2] = pk2(f[4] * rs * g1[0] * sigm_f(a[4]) * silu_f(z[4]), f[5] * rs * g1[1] * sigm_f(a[5]) * silu_f(z[5]));
                o[3] = pk2(f[6] * rs * g1[2] * sigm_f(a[6]) * silu_f(z[6]), f[7] * rs * g1[3] * sigm_f(a[7]) * silu_f(z[7]));
                *(u32x4*)(mixed + (size_t)row * DM + 2048 + lane * 32 + i * 8) = o; }
        }
    }
    for (int i = blockIdx.x * 512 + tid; i < 34 * 3 * 6144; i += gridDim.x * 512) {
        const int c = i % 6144, j = (i / 6144) % 3, s = i / (3 * 6144);
        const size_t row = s < 2 ? (size_t)s * 8192 + 8189 + j : (size_t)NPR + (size_t)(s - 2) * 64 + 61 + j;
        const float v = bf2f(pa[row * NA + c]);
        if (s < 2) p.out[O_CONV_P + ((size_t)s * 3 + j) * 6144 + c] = v; else p.out[O_CONV_S + ((size_t)(s - 2) * 3 + j) * 6144 + c] = v;
    }
}

DI void phase6(const Params& p) {
    int tid_ = threadIdx.x; asm volatile("" : "+v"(tid_));
    const int tid = tid_, lane = tid & 63, wid = tid >> 6;
    const int gw = blockIdx.x * 8 + wid, nw = gridDim.x * 8;
    const float* rowss = (const float*)(p.ws + OFF_ROWSS);
    for (int row = gw; row < NTOK; row += nw) {
        float* yr = p.out + (size_t)row * DM; const float rs = rsqrtf(rowss[row] * (1.f / DM) + 1e-6f);
#pragma unroll
        for (int i = 0; i < 16; ++i) { const f32x4 g = *(const f32x4*)(p.final_g + (lane + 64 * i) * 4); f32x4 v = *(const f32x4*)(yr + (lane + 64 * i) * 4);
            v[0] *= rs * g[0]; v[1] *= rs * g[1]; v[2] *= rs * g[2]; v[3] *= rs * g[3]; *(f32x4*)(yr + (lane + 64 * i) * 4) = v; }
    }
}

DI void phase2(const Params& p, unsigned char* smem) {
    const int G = gridDim.x; int it = blockIdx.x;
    {   PreG pre;
        if (it < 4608) gdn_issue(p, it >> 4, it & 15, threadIdx.x, pre);
#pragma unroll 1
        for (; it < 4608; it += G) { const int nit = it + G; prep_gdn(p, smem, it >> 4, it & 15, pre, nit >> 4, nit & 15, nit < 4608); }
    }
    {   PreM pre;
        if (it < 6912) ml_issue(p, (it - 4608) >> 3, (it - 4608) & 7, threadIdx.x, pre);
#pragma unroll 1
        for (; it < 6912; it += G) { const int nit = it + G; prep_ml(p, smem, (it - 4608) >> 3, (it - 4608) & 7, pre, (nit - 4608) >> 3, (nit - 4608) & 7, nit < 6912); }
    }
}
DI void phase5(const Params& p, unsigned char* smem) {
    pg8::Gemm g; g.A = (const bf16_t*)(p.ws + OFF_MIXED); g.Bt = (const bf16_t*)(p.ws + OFF_BT2); g.M = NTOK; g.N = DM; g.K = DM;
    pg8::StaticOrder S; S.init(g.M, g.N, (int)gridDim.x, (int)blockIdx.x);
    Epi2 E; E.xp = p.xp; E.xs = p.xs; E.y = p.out; E.rowss = (float*)(p.ws + OFF_ROWSS);
    pg8::gemm_phase<Epi2, pg8::StaticOrder, false>((LAS unsigned char*)smem, g, S, E, nullptr);
    __syncthreads();
}

__global__ __launch_bounds__(512, 2) void mega(Params p) {
    extern __shared__ __attribute__((aligned(16))) unsigned char smem[];
    cg::grid_group grid = cg::this_grid();
#ifndef PHMASK
#define PHMASK 127
#endif
#ifndef DBLMASK
#define DBLMASK 0
#endif
#define PHASE(i, call) if constexpr ((PHMASK >> (i)) & 1) { if (p.ph_lo <= (i) && (i) <= p.ph_hi) { call; if ((i) < p.ph_hi) grid.sync(); } }
    PHASE(0, phase0(p, smem))
    PHASE(1, phase1(p, smem))
    PHASE(2, phase2(p, smem))
    PHASE(3, phase3(p, smem))
    PHASE(4, phase4(p, smem))
    PHASE(5, phase5(p, smem))
    PHASE(6, phase6(p))
}

#ifndef N_LAUNCH_SPLIT
#define N_LAUNCH_SPLIT 1
#endif
extern "C" void kernel_launch(void* const* d_in, const int* in_sizes, int n_in, void* d_out, int out_size, void* d_ws, size_t ws_size, hipStream_t stream) {
    static int grid = 0;
    if (grid == 0) {
        if (ws_size < WS_END || n_in != 18) { fprintf(stderr, "kernel_launch: workspace %zu < %zu or n_in %d != 18\n", ws_size, (size_t)WS_END, n_in); grid = -1; return; }
        int dev = 0, cus = 0, per_cu = 0;
        (void)hipGetDevice(&dev); (void)hipDeviceGetAttribute(&cus, hipDeviceAttributeMultiprocessorCount, dev);
        (void)hipFuncSetAttribute((const void*)mega, hipFuncAttributeMaxDynamicSharedMemorySize, LDS_BYTES);
        (void)hipOccupancyMaxActiveBlocksPerMultiprocessor(&per_cu, (const void*)mega, 512, LDS_BYTES);
        if (per_cu < 1) { fprintf(stderr, "kernel_launch: occupancy query says %d blocks/CU\n", per_cu); per_cu = 1; }
        (void)hipGetLastError();
        grid = cus;
    }
    if (grid < 0) return;
    Params p{};
    p.xp = (const float*)d_in[0]; p.xs = (const float*)d_in[1]; p.cache = (const float*)d_in[2]; p.sg = (const float*)d_in[3]; p.sc = (const float*)d_in[4];
    p.sn = (const float*)d_in[5]; p.sm = (const float*)d_in[6]; p.norm_g = (const float*)d_in[7]; p.w_in = (const float*)d_in[8]; p.conv_w = (const float*)d_in[9];
    p.a_log = (const float*)d_in[10]; p.dt_bias = (const float*)d_in[11]; p.gdn_nw = (const float*)d_in[12]; p.b_i = (const float*)d_in[13]; p.b_f = (const float*)d_in[14];
    p.ml_nw = (const float*)d_in[15]; p.w_out = (const float*)d_in[16]; p.final_g = (const float*)d_in[17];
    p.out = (float*)d_out; p.ws = (unsigned char*)d_ws; p.mode3 = 7;
#if N_LAUNCH_SPLIT == 1
    p.ph_lo = 0; p.ph_hi = 6;
    void* args[] = {&p};
    hipError_t e = hipLaunchCooperativeKernel((const void*)mega, dim3(grid), dim3(512), args, LDS_BYTES, stream);
    if (e != hipSuccess) fprintf(stderr, "cooperative launch failed: %s (grid %d)\n", hipGetErrorString(e), grid);
#else
    for (int ph = 0; ph <= 6; ++ph) { p.ph_lo = ph; p.ph_hi = ph; const int reps = 1 + ((DBLMASK >> ph) & 1);
        for (int rep = 0; rep < reps; ++rep) hipLaunchKernelGGL(mega, dim3(grid), dim3(512), LDS_BYTES, stream, p);
        if (ph == 3 && (DBLMASK >> 7)) { p.mode3 = (DBLMASK >> 7) & 7; hipLaunchKernelGGL(mega, dim3(grid), dim3(512), LDS_BYTES, stream, p); p.mode3 = 7; } }
#endif
}
```

```cpp
#include <hip/hip_runtime.h>
#include <hip/hip_cooperative_groups.h>
#include <cstdio>
namespace cg = cooperative_groups;
#define N_LAUNCH_SPLIT 1
#define DBLMASK 0
namespace pg8 {
#define PG8_LAS __attribute__((address_space(3)))
typedef unsigned short bf16_t;
typedef short bf16x8 __attribute__((ext_vector_type(8)));
typedef float f32x4 __attribute__((ext_vector_type(4)));
typedef unsigned u32x4 __attribute__((ext_vector_type(4)));
constexpr int BM = 256, BK = 64, HALF = 128, HTB = HALF * BK * 2  , STAGE_BYTES = 8 * HTB, NXCD = 8, WGM = 8;

__host__ __device__ __forceinline__ int lds_byte(int r, int c) { const int st = (r >> 4) * 2 + (c >> 5), rr = r & 15, cc = c & 31, ob = rr * 64 + cc * 2; return st * 1024 + (ob ^ (((ob >> 9) & 1) << 5)); }
__host__ __device__ __forceinline__ void stage_rc(int b, int& R, int& C) { const int st = b / 1024, sb = b % 1024, swz = sb ^ (((sb >> 9) & 1) << 5); R = (st >> 1) * 16 + swz / 64; C = (st & 1) * 32 + (swz % 64) / 2; }
__host__ __device__ __forceinline__ int perm32(int rho) { const int n = rho >> 4, i = rho & 15; return 8 * (i >> 2) + 4 * n + (i & 3); }

struct Unit { int pm, pn; };
struct Gemm { const bf16_t* A; const bf16_t* Bt; int M, N, K; };

struct StaticOrder {
    int nM, nN, nwg, G, c;
    __host__ __device__ void init(int M, int N, int G_, int c_) { nM = M / BM; nN = N / BM; nwg = nM * nN; G = G_; c = c_; }
    __host__ __device__ bool next(int i, Unit& u) const {
        const long L = (long)i * G + c; if (L >= nwg) return false;
        int wgid = (int)L; { const int q = nwg / NXCD, r = nwg % NXCD, xcd = wgid % NXCD, off = wgid / NXCD; wgid = (xcd < r ? xcd * (q + 1) : r * (q + 1) + (xcd - r) * q) + off; }
        const int nig = WGM * nN, gid = wgid / nig, fm = gid * WGM, gsz = (nM - fm) < WGM ? (nM - fm) : WGM;
        u.pm = fm + ((wgid % nig) % gsz); u.pn = (wgid % nig) / gsz; return true;
    }
    __device__ __forceinline__ void a_ready(const Unit&) const {}
    __device__ __forceinline__ void done(const Unit&) const {}
};
template <class Epi, class Sched, bool STAMP = false>
__device__ __forceinline__ void gemm_phase(PG8_LAS unsigned char* lds, const Gemm g, const Sched& S, const Epi& E, unsigned long long* stamps) {
    const int tid = threadIdx.x, wid = __builtin_amdgcn_readfirstlane(tid >> 6), lane = tid & 63, wr = wid >> 2, wc = wid & 3, fr = lane & 15, fq = lane >> 4;
    const int K = g.K, nt = K / BK;
    int ts_lo = 0, ts_hi = 0, nts = 0; const unsigned long long rt_entry = STAMP ? (unsigned long long)wall_clock64() : 0ull;
#define PG8_STAMP() do { if (STAMP && wid == 0 && nts < 64) { const unsigned long long _c = (unsigned long long)clock64(); \
        ts_lo = (lane == nts) ? (int)(unsigned)_c : ts_lo; ts_hi = (lane == nts) ? (int)(unsigned)(_c >> 32) : ts_hi; ++nts; } } while (0)
    PG8_STAMP();
    unsigned voffA[2], voffB[2];
#pragma unroll
    for (int i = 0; i < 2; ++i) { int R, C; stage_rc(tid * 16 + i * 8192, R, C); const int Rb = Epi::PERM ? ((R & ~31) + perm32(R & 31)) : R;
        voffA[i] = (unsigned)(R * K + C) * 2u; voffB[i] = (unsigned)(Rb * K + C) * 2u; }
    const size_t kstep = (size_t)(BK * 2);
    const size_t hstep = (size_t)HALF * K * 2;
    const size_t tstep = 2 * hstep;
    const unsigned ldsw = (unsigned)wid * 1024u;
    const int aoff = lds_byte(wr * 64 + fr, fq * 8), boff = lds_byte(wc * 32 + fr, fq * 8);
#define PG8_SA(b, h) (((b) * 2 + (h)) * HTB)
#define PG8_SB(b, h) ((4 + (b) * 2 + (h)) * HTB)
#define PG8_STAGE(bufoff, gbase, voff) do { _Pragma("unroll") for (int _i = 0; _i < 2; ++_i) \
        __builtin_amdgcn_global_load_lds((const unsigned*)((const char*)(gbase) + (voff)[_i]), (PG8_LAS unsigned*)(lds + (bufoff) + ldsw + _i * 8192), 16, 0, 0); } while (0)
#define PG8_LDA(dst, b, h) do { _Pragma("unroll") for (int m = 0; m < 4; ++m) _Pragma("unroll") for (int k = 0; k < 2; ++k) dst[m][k] = *(const PG8_LAS bf16x8*)(lds + PG8_SA(b, h) + aoff + m * 2048 + k * 1024); } while (0)
#define PG8_LDB(dst, b, h) do { _Pragma("unroll") for (int n = 0; n < 2; ++n) _Pragma("unroll") for (int k = 0; k < 2; ++k) dst[n][k] = *(const PG8_LAS bf16x8*)(lds + PG8_SB(b, h) + boff + n * 2048 + k * 1024); } while (0)
#define PG8_MMA(ai, bj, At, Bt) do { __builtin_amdgcn_s_setprio(1); _Pragma("unroll") for (int m = 0; m < 4; ++m) _Pragma("unroll") for (int n = 0; n < 2; ++n) _Pragma("unroll") for (int k = 0; k < 2; ++k) \
        acc[ai][bj][m][n] = __builtin_amdgcn_mfma_f32_16x16x32_bf16(Bt[n][k], At[m][k], acc[ai][bj][m][n], 0, 0, 0); __builtin_amdgcn_s_setprio(0); } while (0)
#define PG8_WAIT_V(n) asm volatile("s_waitcnt vmcnt(" #n ")" ::: "memory")
#define PG8_WAIT_L(n) asm volatile("s_waitcnt lgkmcnt(" #n ")" ::: "memory")
#define PG8_BAR __builtin_amdgcn_s_barrier()
#define PG8_SCHED __builtin_amdgcn_sched_barrier(0)
    Unit cur, nxt; int ui = 0;
    if (!S.next(0, cur)) return;
    f32x4 acc[2][2][4][2];
#pragma unroll
    for (int a = 0; a < 2; ++a)
#pragma unroll
        for (int b = 0; b < 2; ++b)
#pragma unroll
            for (int m = 0; m < 4; ++m)
#pragma unroll
                for (int n = 0; n < 2; ++n) acc[a][b][m][n] = (f32x4){0.f, 0.f, 0.f, 0.f};
    bf16x8 At[4][2], B0[2][2], B1[2][2];
    const char* cA = (const char*)g.A + (size_t)cur.pm * tstep; const char* cB = (const char*)g.Bt + (size_t)cur.pn * tstep;
    S.a_ready(cur);
    PG8_STAGE(PG8_SB(0, 0), cB, voffB); PG8_STAGE(PG8_SA(0, 0), cA, voffA); PG8_STAGE(PG8_SB(0, 1), cB + hstep, voffB); PG8_STAGE(PG8_SA(0, 1), cA + hstep, voffA);
    if (wr == 1) PG8_BAR;
    PG8_WAIT_V(4); PG8_BAR;
    PG8_STAGE(PG8_SB(1, 0), cB + kstep, voffB); PG8_STAGE(PG8_SA(1, 0), cA + kstep, voffA); PG8_STAGE(PG8_SB(1, 1), cB + hstep + kstep, voffB);
    PG8_WAIT_V(6); PG8_BAR;
    PG8_STAMP();
    for (;;) {
        const bool has_next = S.next(ui + 1, nxt);
        const char* nA = has_next ? (const char*)g.A + (size_t)nxt.pm * tstep : cA; const char* nB = has_next ? (const char*)g.Bt + (size_t)nxt.pn * tstep : cB;
        for (int t = 0; t < nt; t += 2) {
            const bool last = (t == nt - 2);
            const char* a1 = cA + (size_t)(t + 1) * kstep;
            const char* a2 = last ? nA : cA + (size_t)(t + 2) * kstep; const char* b2 = last ? nB : cB + (size_t)(t + 2) * kstep;
            const char* a3 = a2 + kstep; const char* b3 = b2 + kstep;
            if (last && has_next) S.a_ready(nxt);
            PG8_LDB(B0, 0, 0); PG8_SCHED; PG8_LDA(At, 0, 0); PG8_STAGE(PG8_SA(1, 1), a1 + hstep, voffA);
            PG8_WAIT_L(8); PG8_BAR; PG8_WAIT_L(0); PG8_MMA(0, 0, At, B0); PG8_BAR; PG8_SCHED;
            PG8_LDB(B1, 0, 1); PG8_STAGE(PG8_SB(0, 0), b2, voffB);
            PG8_BAR; PG8_WAIT_L(0); PG8_MMA(0, 1, At, B1); PG8_BAR;
            PG8_LDA(At, 0, 1); PG8_STAGE(PG8_SA(0, 0), a2, voffA);
            PG8_BAR; PG8_WAIT_L(0); PG8_MMA(1, 0, At, B0); PG8_BAR; PG8_SCHED;
            PG8_STAGE(PG8_SB(0, 1), b2 + hstep, voffB);
            PG8_WAIT_V(6); PG8_BAR; PG8_MMA(1, 1, At, B1); PG8_BAR;
            PG8_LDB(B0, 1, 0); PG8_SCHED; PG8_LDA(At, 1, 0); PG8_STAGE(PG8_SA(0, 1), a2 + hstep, voffA);
            PG8_WAIT_L(8); PG8_BAR; PG8_WAIT_L(0); PG8_MMA(0, 0, At, B0); PG8_BAR; PG8_SCHED;
            PG8_LDB(B1, 1, 1); PG8_STAGE(PG8_SB(1, 0), b3, voffB);
            PG8_BAR; PG8_WAIT_L(0); PG8_MMA(0, 1, At, B1); PG8_BAR;
            PG8_LDA(At, 1, 1); PG8_STAGE(PG8_SA(1, 0), a3, voffA);
            PG8_BAR; PG8_WAIT_L(0); PG8_MMA(1, 0, At, B0); PG8_BAR; PG8_SCHED;
            PG8_STAGE(PG8_SB(1, 1), b3 + hstep, voffB);
            PG8_WAIT_V(6); PG8_BAR; PG8_MMA(1, 1, At, B1); PG8_BAR;
        }
        PG8_STAMP();
        if constexpr (!Epi::AFTER_DRAIN) { E(acc, cur, wr, wc, fr, fq); S.done(cur); }
        PG8_STAMP();
        if (!has_next) break;
#pragma unroll
        for (int a = 0; a < 2; ++a)
#pragma unroll
            for (int b = 0; b < 2; ++b)
#pragma unroll
                for (int m = 0; m < 4; ++m)
#pragma unroll
                    for (int n = 0; n < 2; ++n) acc[a][b][m][n] = (f32x4){0.f, 0.f, 0.f, 0.f};
        cur = nxt; cA = nA; cB = nB; ++ui;
    }
    PG8_WAIT_V(0);
    if (wr == 0) PG8_BAR;
    PG8_BAR;
    if constexpr (Epi::AFTER_DRAIN) { E.fused(acc, cur, wr, wc, fr, fq, lds, wid, lane); S.done(cur); }
    PG8_STAMP();
    if (STAMP && wid == 0) { stamps[lane] = lane < nts ? (((unsigned long long)(unsigned)ts_hi << 32) | (unsigned)ts_lo) : 0ull;
        if (lane == 62) stamps[62] = rt_entry; if (lane == 63) stamps[63] = (unsigned long long)wall_clock64(); }
#undef PG8_STAMP
#undef PG8_SA
#undef PG8_SB
#undef PG8_STAGE
#undef PG8_LDA
#undef PG8_LDB
#undef PG8_MMA
#undef PG8_WAIT_V
#undef PG8_WAIT_L
#undef PG8_BAR
#undef PG8_SCHED
}
}
using pg8::bf16_t; using pg8::bf16x8; using pg8::f32x4; using pg8::u32x4;
typedef float f32x16 __attribute__((ext_vector_type(16)));
typedef __bf16 bf16x2_t __attribute__((ext_vector_type(2)));
typedef float f32x2_t __attribute__((ext_vector_type(2)));
#define DI __device__ __forceinline__
#define LAS __attribute__((address_space(3)))
#define GAS __attribute__((address_space(1)))
#define MFMA32(a, b, c) __builtin_amdgcn_mfma_f32_32x32x16_bf16((a), (b), (c), 0, 0, 0)

constexpr int DM = 4096, NTOK = 18432, NPR = 16384, NA = 10240, NB = 6144, N1 = 16640;
constexpr size_t BLOB = 73728;
constexpr size_t OFF_H = 0, OFF_PREPG = 29360128ull, OFF_BT1 = 285212672ull, OFF_MIXED = OFF_PREPG, OFF_BT2 = OFF_MIXED + 150994944ull,
    OFF_PA = OFF_BT1 + 136314880ull, OFF_PB = OFF_PA + (size_t)NTOK * NA * 2, OFF_ORAW0 = OFF_PB + (size_t)NTOK * NB * 2, OFF_ROWSS = OFF_ORAW0 + 9216ull * 4096, WS_END = OFF_ROWSS + 73728;
static_assert(OFF_PREPG + 4608ull * BLOB == OFF_BT1 + 10240ull * 8192, "overlay must end where the protected Bt1 rows start");
constexpr size_t DO_PREPM = 0, DO_NUM = 2304ull * BLOB, DO_ORAW1 = DO_NUM + (size_t)NTOK * 2048 * 2, DO_GATES = DO_ORAW1 + 9216ull * 4096, DO_EGL = DO_GATES + (size_t)NTOK * 64 * 4,
    DO_MB = DO_EGL + 18432, DO_MDMAX = DO_MB + 589824, DO_MRS = DO_MDMAX + 589824, DO_KN = DO_MRS + 589824, DO_NCS = DO_KN + 1179648, DO_MCS = DO_NCS + 1179648,
    DO_TABK = DO_MCS + 9216, DO_TABD = DO_TABK + 18944, DO_END = DO_TABD + 1536;
static_assert(DO_END <= 301989888ull, "d_out scratch must fit in the y region");
constexpr int NKEPT = 4344, NDEF = 336;
constexpr size_t O_Y = 0, O_CONV_P = 75497472ull, O_GDN_P = O_CONV_P + 36864, O_C_P = O_GDN_P + 524288, O_N_P = O_C_P + 524288, O_M_P = O_N_P + 2048,
    O_CONV_S = O_M_P + 16, O_GDN_S = O_CONV_S + 589824, O_C_S = O_GDN_S + 8388608, O_N_S = O_C_S + 8388608, O_M_S = O_N_S + 32768;
constexpr int LDS_BYTES = 155648;

struct Params {
    const float *xp, *xs, *cache, *sg, *sc, *sn, *sm, *norm_g, *w_in, *conv_w, *a_log, *dt_bias, *gdn_nw, *b_i, *b_f, *ml_nw, *w_out, *final_g;
    float* out; unsigned char* ws; int ph_lo, ph_hi, mode3, pad_;
};

DI int gidx(int cgi, int hd) { return cgi < 256 ? (((cgi >> 7) * 16 + hd) * 128 + (cgi & 127)) : (4096 + (cgi - 256) * 16 + hd); }
DI int midx(int cgi, int hd) { return cgi < 256 ? (((cgi >> 7) * 8 + hd) * 128 + (cgi & 127)) : (2048 + (cgi - 256) * 8 + hd); }
DI bf16_t* oraw_blk(const Params& p, int gi) { return gi < 2304 ? (bf16_t*)(p.ws + OFF_ORAW0) + (size_t)gi * 8192 : (bf16_t*)((unsigned char*)p.out + DO_ORAW1) + (size_t)(gi - 2304) * 8192; }
DI float bf2f(bf16_t b) { return __uint_as_float(((unsigned)b) << 16); }
DI unsigned pk2(float a, float b) { f32x2_t v = {a, b}; bf16x2_t r = __builtin_convertvector(v, bf16x2_t); return __builtin_bit_cast(unsigned, r); }
DI bf16_t f2bf(float a) { return (bf16_t)(pk2(a, 0.f) & 0xffffu); }
DI bf16x8 pack8(float a0, float a1, float a2, float a3, float a4, float a5, float a6, float a7) {
    u32x4 p; p[0] = pk2(a0, a1); p[1] = pk2(a2, a3); p[2] = pk2(a4, a5); p[3] = pk2(a6, a7); return __builtin_bit_cast(bf16x8, p); }
DI bf16x8 pack_step(const f32x16& x, int s) { return pack8(x[8 * s], x[8 * s + 1], x[8 * s + 2], x[8 * s + 3], x[8 * s + 4], x[8 * s + 5], x[8 * s + 6], x[8 * s + 7]); }
DI int crow(int reg, int h) { return (reg & 3) + 8 * (reg >> 2) + 4 * h; }
DI float wave_sum(float v) { for (int o = 32; o >= 1; o >>= 1) v += __shfl_xor(v, o); return v; }
DI bf16x8 ld8f(const float* p) { const f32x4 a = *(const f32x4*)p, b = *(const f32x4*)(p + 4); return pack8(a[0], a[1], a[2], a[3], b[0], b[1], b[2], b[3]); }
DI float silu_f(float y) { return y * __builtin_amdgcn_rcpf(1.f + __expf(-y)); }
DI float sigm_f(float y) { return __builtin_amdgcn_rcpf(1.f + __expf(-y)); }
DI float softplus_f(float x) { return fmaxf(x, 0.f) + log1pf(expf(-fabsf(x))); }

DI int emap1(int n) {
    if (n < 6144) return n;
    if (n < 10240) return 8224 + (n - 6144);
    if (n < 12288) return 6144 + (n - 10240);
    if (n < 16384) return 12320 + (n - 12288);
    if (n < 16416) return 8192 + (n - 16384);
    if (n < 16432) return n;
    return -1;
}
DI void transpose_tiles(const Params& p, unsigned char* smem, int tid, bool second) {
    float* tl = (float*)smem;
    bf16_t* dst = (bf16_t*)(p.ws + (second ? OFF_BT2 : OFF_BT1));
    const int NT = second ? 32 * 32 : (N1 / 128) * 32;
    const float* src = second ? p.w_out : p.w_in; const int ld = second ? 4096 : 16432;
    const int nn = tid & 127;
    for (int tt = blockIdx.x; tt < NT; tt += gridDim.x) {
        const int n0 = (tt >> 5) * 128, d0 = (tt & 31) * 128;
        const int e = second ? (n0 + nn) : emap1(n0 + nn);
        float v[32];
#pragma unroll
        for (int i = 0; i < 32; ++i) { const int dd = (tid >> 7) + 4 * i; v[i] = e >= 0 ? src[(size_t)(d0 + dd) * ld + e] : 0.f; }
#pragma unroll
        for (int i = 0; i < 32; ++i) { const int dd = (tid >> 7) + 4 * i; tl[dd * 129 + nn] = v[i]; }
        __syncthreads();
        const int ds = (tid & 15) * 8;
#pragma unroll
        for (int k = 0; k < 4; ++k) { const int nn2 = (tid >> 4) + 32 * k;
            const bf16x8 o = pack8(tl[(ds + 0) * 129 + nn2], tl[(ds + 1) * 129 + nn2], tl[(ds + 2) * 129 + nn2], tl[(ds + 3) * 129 + nn2], tl[(ds + 4) * 129 + nn2], tl[(ds + 5) * 129 + nn2], tl[(ds + 6) * 129 + nn2], tl[(ds + 7) * 129 + nn2]);
            *(bf16x8*)(dst + (size_t)(n0 + nn2) * DM + d0 + ds) = o; }
        __syncthreads();
    }
}
DI void phase0(const Params& p, unsigned char* smem) {
    int tid_ = threadIdx.x; asm volatile("" : "+v"(tid_));
    const int tid = tid_, lane = tid & 63, wid = tid >> 6;
    const int gw = blockIdx.x * 8 + wid, nw = gridDim.x * 8;
    bf16_t* hb = (bf16_t*)(p.ws + OFF_H);
    for (int row = gw; row < NTOK; row += nw) {
        const float* xr = row < NPR ? p.xp + (size_t)row * DM : p.xs + (size_t)(row - NPR) * DM;
        f32x4 v[16]; float ss = 0.f;
#pragma unroll
        for (int i = 0; i < 16; ++i) { v[i] = *(const f32x4*)(xr + (lane + 64 * i) * 4); ss += v[i][0] * v[i][0] + v[i][1] * v[i][1] + v[i][2] * v[i][2] + v[i][3] * v[i][3]; }
        ss = wave_sum(ss);
        const float rs = rsqrtf(ss * (1.f / DM) + 1e-6f);
#pragma unroll
        for (int i = 0; i < 16; ++i) { const f32x4 g = *(const f32x4*)(p.norm_g + (lane + 64 * i) * 4);
            uint2 o; o.x = pk2(v[i][0] * rs * g[0], v[i][1] * rs * g[1]); o.y = pk2(v[i][2] * rs * g[2], v[i][3] * rs * g[3]);
            *(uint2*)(hb + (size_t)row * DM + (lane + 64 * i) * 4) = o; }
    }
    float* rowss = (float*)(p.ws + OFF_ROWSS);
    for (int i = blockIdx.x * 512 + tid; i < NTOK; i += gridDim.x * 512) rowss[i] = 0.f;
    transpose_tiles(p, smem, tid, false);
    if (blockIdx.x == 0 && wid == 0) {
        unsigned* tk = (unsigned*)((unsigned char*)p.out + DO_TABK); unsigned* td = (unsigned*)((unsigned char*)p.out + DO_TABD);
        int nk = 0, nd = 0;
        for (int base = 0; base < 4680; base += 64) { const int wg = base + lane; const bool valid = wg < 4680;
            const int gid = wg / 520, rem = wg - gid * 520, pm = gid * 8 + (rem & 7), pn = rem >> 3;
            const bool def = valid && pn >= 40 && pn < 64 && pm < 14, keep = valid && !def;
            const unsigned long long mk = __ballot(keep), md = __ballot(def); const unsigned long long below = (1ull << lane) - 1ull;
            if (keep) tk[nk + __popcll(mk & below)] = (unsigned)(pm << 8 | pn);
            if (def) td[nd + __popcll(md & below)] = (unsigned)(pm << 8 | pn);
            nk += __popcll(mk); nd += __popcll(md); }
    }
}

struct Epi1 {
    static constexpr bool PERM = true, AFTER_DRAIN = false;
    bf16_t* pa; bf16_t* pb; float* gates;
    DI void operator()(const f32x4 (&acc)[2][2][4][2], const pg8::Unit& u, int wr, int wc, int fr, int fq) const {
        const int row0 = u.pm * 256 + wr * 64 + fr;
        if (u.pn < 64) {
            bf16_t* base; int ldc, colt;
            if (u.pn < 40) { base = pa; ldc = NA; colt = u.pn * 256; } else { base = pb; ldc = NB; colt = (u.pn - 40) * 256; }
            const int col0 = colt + wc * 32 + 8 * fq;
#pragma unroll
            for (int ai = 0; ai < 2; ++ai)
#pragma unroll
                for (int m = 0; m < 4; ++m) { bf16_t* rowp = base + (size_t)(row0 + ai * 128 + m * 16) * ldc + col0;
#pragma unroll
                    for (int bj = 0; bj < 2; ++bj) { const f32x4 v0 = acc[ai][bj][m][0], v1 = acc[ai][bj][m][1];
                        u32x4 w; w[0] = pk2(v0[0], v0[1]); w[1] = pk2(v0[2], v0[3]); w[2] = pk2(v1[0], v1[1]); w[3] = pk2(v1[2], v1[3]);
                        *(u32x4*)(rowp + bj * 128) = w; } }
        } else if (wc < 2) {
#pragma unroll
            for (int ai = 0; ai < 2; ++ai)
#pragma unroll
                for (int m = 0; m < 4; ++m) { float* rowp = gates + (size_t)(row0 + ai * 128 + m * 16) * 64 + wc * 32 + 8 * fq;
                    *(f32x4*)rowp = acc[ai][0][m][0]; *(f32x4*)(rowp + 4) = acc[ai][0][m][1]; }
        }
    }
};
struct Epi2 {
    static constexpr bool PERM = false, AFTER_DRAIN = false;
    const float* xp; const float* xs; float* y; float* rowss;
    DI void operator()(const f32x4 (&acc)[2][2][4][2], const pg8::Unit& u, int wr, int wc, int fr, int fq) const {
        const int row0 = u.pm * 256 + wr * 64 + fr, col0 = u.pn * 256 + wc * 32 + 4 * fq;
#pragma unroll
        for (int ai = 0; ai < 2; ++ai)
#pragma unroll
            for (int m = 0; m < 4; ++m) { const int row = row0 + ai * 128 + m * 16;
                const float* xr = (row < NPR ? xp + (size_t)row * DM : xs + (size_t)(row - NPR) * DM) + col0; float* yr = y + (size_t)row * DM + col0; float ssq = 0.f;
#pragma unroll
                for (int bj = 0; bj < 2; ++bj)
#pragma unroll
                    for (int n = 0; n < 2; ++n) { const f32x4 v = acc[ai][bj][m][n] + *(const f32x4*)(xr + bj * 128 + n * 16); *(f32x4*)(yr + bj * 128 + n * 16) = v;
                        ssq += v[0] * v[0] + v[1] * v[1] + v[2] * v[2] + v[3] * v[3]; }
                ssq += __shfl_xor(ssq, 16); ssq += __shfl_xor(ssq, 32);
                if (fq == 0) atomicAdd(rowss + row, ssq); }
    }
};

template <class F> DI void emit_frags(int tid, unsigned char* dst, int MT, int KS, F elem, int nthr = 512) {
    for (int idx = tid; idx < MT * KS * 64; idx += nthr) {
        const int f = idx >> 6, l = idx & 63, mt = f / KS, ks = f - mt * KS, r = l & 31, h = l >> 5;
        const int row = mt * 32 + r, cb = (ks >> 1) * 32 + (ks & 1) * 16 + 4 * h;
        const bf16x8 o = pack8(elem(row, cb), elem(row, cb + 1), elem(row, cb + 2), elem(row, cb + 3), elem(row, cb + 8), elem(row, cb + 9), elem(row, cb + 10), elem(row, cb + 11));
        *(bf16x8*)(dst + (size_t)idx * 16) = o;
    }
}

struct PreG { u32x4 raw[11]; f32x4 w0[4], w1[4]; float gbv, gav; };
DI void gdn_issue(const Params& p, int cgi, int hd, int tid, PreG& pre) {
    const int row0 = cgi * 64; const bool sample = cgi >= 256; const bool first = sample || ((cgi & 127) == 0);
    const bf16_t* pa = (const bf16_t*)(p.ws + OFF_PA); const float* gates = (const float*)((unsigned char*)p.out + DO_GATES);
    if (tid < 384) {
        const int which = tid >> 7, cgp = (tid >> 3) & 15, trun = tid & 7;
        const int cc0 = which * 2048 + hd * 128 + cgp * 8;
#pragma unroll
        for (int j = 0; j < 4; ++j) { pre.w0[j] = *(const f32x4*)(p.conv_w + j * 6144 + cc0); pre.w1[j] = *(const f32x4*)(p.conv_w + j * 6144 + cc0 + 4); }
#pragma unroll
        for (int i = 0; i < 11; ++i) { const int tt = trun * 8 - 3 + i;
            if (tt >= 0 || !first) pre.raw[i] = *(const u32x4*)(pa + (size_t)(row0 + tt) * NA + cc0);
            else if (sample) { const float* cp = p.cache + ((size_t)(cgi - 256) * 3 + (3 + tt)) * 6144 + cc0; const f32x4 a = *(const f32x4*)cp, b = *(const f32x4*)(cp + 4);
                pre.raw[i][0] = pk2(a[0], a[1]); pre.raw[i][1] = pk2(a[2], a[3]); pre.raw[i][2] = pk2(b[0], b[1]); pre.raw[i][3] = pk2(b[2], b[3]); }
            else { pre.raw[i][0] = 0u; pre.raw[i][1] = 0u; pre.raw[i][2] = 0u; pre.raw[i][3] = 0u; } }
    }
    if (tid >= 384 && tid < 448) { pre.gbv = gates[(size_t)(row0 + tid - 384) * 64 + hd]; pre.gav = gates[(size_t)(row0 + tid - 384) * 64 + 16 + hd]; }
}
DI void prep_gdn(const Params& p, unsigned char* smem, int cgi, int hd, PreG& pre, int ncgi, int nhd, bool has_next) {
    int tid_ = threadIdx.x; asm volatile("" : "+v"(tid_));
    const int tid = tid_, lane = tid & 63, wid = tid >> 6, r = lane & 31, h = lane >> 5;
    float* qf = (float*)smem; float* kf = qf + 64 * 132; float* vf = kf + 64 * 132; float* am = vf + 64 * 132; float* qk = am + 64 * 68; float* tm = qk + 64 * 68; float* sc = tm + 64 * 68;
    float* Gs = sc; float* betas = sc + 64; float* eGs = sc + 128; float* decs = sc + 192;
    const int row0 = cgi * 64; const bool sample = cgi >= 256; const bool first = sample || ((cgi & 127) == 0);
    const bf16_t* pa = (const bf16_t*)(p.ws + OFF_PA); const float* gates = (const float*)((unsigned char*)p.out + DO_GATES);
    unsigned char* blob = p.ws + OFF_PREPG + (size_t)gidx(cgi, hd) * BLOB;
    if (tid < 384) {
        const int which = tid >> 7, cgp = (tid >> 3) & 15, trun = tid & 7;
        float* dstm = which == 0 ? qf : which == 1 ? kf : vf;
#pragma unroll
        for (int o = 0; o < 8; ++o) { f32x4 y0, y1;
#pragma unroll
            for (int c = 0; c < 8; ++c) { float acc = 0.f;
#pragma unroll
                for (int j = 0; j < 4; ++j) { const unsigned wd = pre.raw[o + j][c >> 1]; const float xv = (c & 1) ? __uint_as_float(wd & 0xffff0000u) : __uint_as_float(wd << 16);
                    acc += xv * (c < 4 ? pre.w0[j][c & 3] : pre.w1[j][c & 3]); }
                if (c < 4) y0[c & 3] = silu_f(acc); else y1[c & 3] = silu_f(acc); }
            *(f32x4*)(dstm + (trun * 8 + o) * 132 + cgp * 8) = y0; *(f32x4*)(dstm + (trun * 8 + o) * 132 + cgp * 8 + 4) = y1;
            if (which < 2) qk[(which * 64 + trun * 8 + o) * 16 + cgp] = y0[0] * y0[0] + y0[1] * y0[1] + y0[2] * y0[2] + y0[3] * y0[3] + y1[0] * y1[0] + y1[1] * y1[1] + y1[2] * y1[2] + y1[3] * y1[3]; }
    }
    const float gbv = pre.gbv, gav = pre.gav;
    if (has_next) gdn_issue(p, ncgi, nhd, tid, pre);
    for (int idx = tid; idx < 64 * 68; idx += 512) tm[idx] = 0.f;
    if (tid >= 384 && tid < 448) { const int tg = tid - 384;
        const float beta = 1.f / (1.f + expf(-gbv));
        const float g = -expf(p.a_log[hd]) * softplus_f(gav + p.dt_bias[hd]);
        float G = g;
#pragma unroll
        for (int o = 1; o < 64; o <<= 1) { const float t2 = __shfl_up(G, o); if (lane >= o) G += t2; }
        const float GL = __shfl(G, 63);
        Gs[tg] = G; betas[tg] = beta; eGs[tg] = expf(G); decs[tg] = expf(GL - G);
        if (tg == 63) ((float*)((unsigned char*)p.out + DO_EGL))[cgi * 16 + hd] = expf(G);
    }
    __syncthreads();
    {
        const int t = tid >> 3, part = tid & 7; float* qp = qf + t * 132 + part * 16; float* kp = kf + t * 132 + part * 16;
        float sq = 0.f, sk = 0.f;
#pragma unroll
        for (int i = 0; i < 4; ++i) { const f32x4 a = *(const f32x4*)(qk + t * 16 + 4 * i), b2 = *(const f32x4*)(qk + (64 + t) * 16 + 4 * i); sq += a[0] + a[1] + a[2] + a[3]; sk += b2[0] + b2[1] + b2[2] + b2[3]; }
        const float s1 = rsqrtf(sq + 1e-6f) * 0.08838834764831845f, s2 = rsqrtf(sk + 1e-6f);
#pragma unroll
        for (int i = 0; i < 4; ++i) { *(f32x4*)(qp + 4 * i) = *(const f32x4*)(qp + 4 * i) * s1; *(f32x4*)(kp + 4 * i) = *(const f32x4*)(kp + 4 * i) * s2; }
    }
    __syncthreads();
    { const int mat = wid >> 2, ti = (wid >> 1) & 1, tj = wid & 1; float* dstm = mat ? qk : am;
      if (ti == 0 && tj == 1) {
#pragma unroll
          for (int i = 0; i < 16; ++i) dstm[crow(i, h) * 68 + 32 + r] = 0.f;
      } else {
          const float* A = mat ? qf : kf; f32x16 acc;
#pragma unroll
          for (int i = 0; i < 16; ++i) acc[i] = 0.f;
#pragma unroll
          for (int ks = 0; ks < 8; ++ks) acc = MFMA32(ld8f(A + (ti * 32 + r) * 132 + ks * 16 + h * 8), ld8f(kf + (tj * 32 + r) * 132 + ks * 16 + h * 8), acc);
#pragma unroll
          for (int i = 0; i < 16; ++i) { const int t = ti * 32 + crow(i, h), s = tj * 32 + r;
              const bool keep = mat ? (s <= t) : (s < t); const float d = keep ? __expf(Gs[t] - Gs[s]) : 0.f;
              dstm[t * 68 + s] = mat ? acc[i] * d : betas[t] * acc[i] * d; }
      } }
    __syncthreads();
    if (tid >= 64) {
        emit_frags(tid - 64, blob + 32768, 2, 4, [&](int row, int col) { return qk[row * 68 + col]; }, 448);
        emit_frags(tid - 64, blob + 16384, 2, 8, [&](int row, int col) { return eGs[row] * qf[row * 132 + col]; }, 448);
        emit_frags(tid - 64, blob + 40960, 4, 4, [&](int row, int col) { return kf[col * 132 + row] * decs[col]; }, 448);
    }
    if (tid < 64) {
        const int b0 = (tid >> 4) * 16, col = tid & 15; float a[120], x[16];
#pragma unroll
        for (int i = 1; i < 16; ++i)
#pragma unroll
            for (int s2 = 0; s2 < i; ++s2) a[i * (i - 1) / 2 + s2] = am[(b0 + i) * 68 + b0 + s2];
#pragma unroll
        for (int i = 0; i < 16; ++i) { float v = (i == col) ? 1.f : 0.f;
#pragma unroll
            for (int s2 = 0; s2 < i; ++s2) v -= a[i * (i - 1) / 2 + s2] * x[s2];
            x[i] = v; tm[(b0 + i) * 68 + b0 + col] = v; }
        asm volatile("s_waitcnt lgkmcnt(0)" ::: "memory");
        const int r16 = r & 15;
#pragma unroll
        for (int B = 0; B < 2; ++B) {
            const int c0 = 32 * B; f32x16 mm, tt;
#pragma unroll
            for (int i = 0; i < 16; ++i) { mm[i] = 0.f; tt[i] = 0.f; }
            float bv[8];
#pragma unroll
            for (int j = 0; j < 8; ++j) bv[j] = tm[(c0 + 8 * h + j) * 68 + c0 + r16];
            mm = MFMA32(ld8f(am + (c0 + 16 + r16) * 68 + c0 + 8 * h), pack8(bv[0], bv[1], bv[2], bv[3], bv[4], bv[5], bv[6], bv[7]), mm);
            const float* tp = tm + (c0 + 16 + r16) * 68 + c0 + 16 + 4 * h; const f32x4 lo = *(const f32x4*)tp, hi = *(const f32x4*)(tp + 8);
            tt = MFMA32(pack8(lo[0], lo[1], lo[2], lo[3], hi[0], hi[1], hi[2], hi[3]), pack_step(mm, 0), tt);
#pragma unroll
            for (int i = 0; i < 8; ++i) if (r < 16) tm[(c0 + 16 + crow(i, h)) * 68 + c0 + r] = -tt[i];
        }
        asm volatile("s_waitcnt lgkmcnt(0)" ::: "memory");
    }
    if (wid == 0) {
        f32x16 m1;
#pragma unroll
        for (int i = 0; i < 16; ++i) m1[i] = 0.f;
#pragma unroll
        for (int ks = 0; ks < 2; ++ks) { float bv[8];
#pragma unroll
            for (int j = 0; j < 8; ++j) bv[j] = tm[(ks * 16 + 8 * h + j) * 68 + r];
            m1 = MFMA32(ld8f(am + (32 + r) * 68 + ks * 16 + 8 * h), pack8(bv[0], bv[1], bv[2], bv[3], bv[4], bv[5], bv[6], bv[7]), m1); }
        f32x16 t21;
#pragma unroll
        for (int i = 0; i < 16; ++i) t21[i] = 0.f;
#pragma unroll
        for (int s2 = 0; s2 < 2; ++s2) { const float* tp = tm + (32 + r) * 68 + 32 + 16 * s2 + 4 * h; const f32x4 lo = *(const f32x4*)tp, hi = *(const f32x4*)(tp + 8);
            t21 = MFMA32(pack8(lo[0], lo[1], lo[2], lo[3], hi[0], hi[1], hi[2], hi[3]), pack_step(m1, s2), t21); }
#pragma unroll
        for (int i = 0; i < 16; ++i) tm[(32 + crow(i, h)) * 68 + r] = -t21[i];
    }
    __syncthreads();
    { const int nt = wid & 3, mat = wid >> 2; const float* src = mat ? vf : kf;
      f32x16 acc0, acc1;
#pragma unroll
      for (int i = 0; i < 16; ++i) { acc0[i] = 0.f; acc1[i] = 0.f; }
#pragma unroll
      for (int ks = 0; ks < 4; ++ks) { float bv[8];
#pragma unroll
          for (int j = 0; j < 8; ++j) { const int s = ks * 16 + 8 * h + j; bv[j] = src[s * 132 + nt * 32 + r] * (mat ? betas[s] : betas[s] * eGs[s]); }
          const bf16x8 b = pack8(bv[0], bv[1], bv[2], bv[3], bv[4], bv[5], bv[6], bv[7]);
          const bf16x8 t0 = ld8f(tm + r * 68 + ks * 16 + 8 * h), t1 = ld8f(tm + (32 + r) * 68 + ks * 16 + 8 * h);
          if (mat) { acc0 = MFMA32(t0, b, acc0); acc1 = MFMA32(t1, b, acc1); }
          else { acc0 = MFMA32(b, t0, acc0); acc1 = MFMA32(b, t1, acc1); } }
      if (mat) {
          unsigned char* d0 = blob + 57344 + ((size_t)((0 * 4 + nt) * 64 + lane)) * 32; unsigned char* d1 = blob + 57344 + ((size_t)((1 * 4 + nt) * 64 + lane)) * 32;
          *(bf16x8*)d0 = pack_step(acc0, 0); *(bf16x8*)(d0 + 16) = pack_step(acc0, 1);
          *(bf16x8*)d1 = pack_step(acc1, 0); *(bf16x8*)(d1 + 16) = pack_step(acc1, 1);
      } else {
#pragma unroll
          for (int i = 0; i < 16; ++i) { acc0[i] = -acc0[i]; acc1[i] = -acc1[i]; }
#pragma unroll
          for (int s2 = 0; s2 < 2; ++s2) {
              *(bf16x8*)(blob + ((size_t)((0 * 8 + 2 * nt + s2) * 64 + lane)) * 16) = pack_step(acc0, s2);
              *(bf16x8*)(blob + ((size_t)((1 * 8 + 2 * nt + s2) * 64 + lane)) * 16) = pack_step(acc1, s2); }
      } }
    __syncthreads();
}

struct PreM { u32x4 qr[2], kr[2], vr[4]; float mi, mf; };
DI void ml_issue(const Params& p, int cgi, int hd, int tid, PreM& pre) {
    const int row0 = cgi * 64; const bf16_t* pa = (const bf16_t*)(p.ws + OFF_PA); const float* gates = (const float*)((unsigned char*)p.out + DO_GATES);
#pragma unroll
    for (int it = 0; it < 2; ++it) { const int idx = tid + 512 * it, t = idx >> 4, cgp = idx & 15;
        pre.qr[it] = *(const u32x4*)(pa + (size_t)(row0 + t) * NA + 6144 + hd * 128 + cgp * 8); pre.kr[it] = *(const u32x4*)(pa + (size_t)(row0 + t) * NA + 7168 + hd * 128 + cgp * 8); }
#pragma unroll
    for (int it = 0; it < 4; ++it) { const int idx = tid + 512 * it, t = idx >> 5, cgp = idx & 31; pre.vr[it] = *(const u32x4*)(pa + (size_t)(row0 + t) * NA + 8192 + hd * 256 + cgp * 8); }
    if (tid < 64) { pre.mi = gates[(size_t)(row0 + tid) * 64 + 32 + hd]; pre.mf = gates[(size_t)(row0 + tid) * 64 + 40 + hd]; }
}
DI void prep_ml(const Params& p, unsigned char* smem, int cgi, int hd, PreM& pre, int ncgi, int nhd, bool has_next) {
    int tid_ = threadIdx.x; asm volatile("" : "+v"(tid_));
    const int tid = tid_, lane = tid & 63, wid = tid >> 6, r = lane & 31, h = lane >> 5;
    float* qf = (float*)smem; float* kf = qf + 64 * 132; bf16_t* vb = (bf16_t*)(smem + 67584); float* pm = (float*)(smem + 101376); float* sc = (float*)(smem + 153600);
    float* as_ = sc; float* pms = sc + 64; float* wend = sc + 128;
    const int row0 = cgi * 64; const bf16_t* pa = (const bf16_t*)(p.ws + OFF_PA); const float* gates = (const float*)((unsigned char*)p.out + DO_GATES);
    unsigned char* blob = (unsigned char*)p.out + DO_PREPM + (size_t)midx(cgi, hd) * BLOB;
#pragma unroll
    for (int it = 0; it < 2; ++it) { const int idx = tid + 512 * it, t = idx >> 4, cgp = idx & 15;
        const u32x4 qr = pre.qr[it], kr = pre.kr[it];
        f32x4 a, b, c2, d; const float ks = 0.08838834764831845f;
        a[0] = __uint_as_float(qr[0] << 16); a[1] = __uint_as_float(qr[0] & 0xffff0000u); a[2] = __uint_as_float(qr[1] << 16); a[3] = __uint_as_float(qr[1] & 0xffff0000u);
        b[0] = __uint_as_float(qr[2] << 16); b[1] = __uint_as_float(qr[2] & 0xffff0000u); b[2] = __uint_as_float(qr[3] << 16); b[3] = __uint_as_float(qr[3] & 0xffff0000u);
        c2[0] = ks * __uint_as_float(kr[0] << 16); c2[1] = ks * __uint_as_float(kr[0] & 0xffff0000u); c2[2] = ks * __uint_as_float(kr[1] << 16); c2[3] = ks * __uint_as_float(kr[1] & 0xffff0000u);
        d[0] = ks * __uint_as_float(kr[2] << 16); d[1] = ks * __uint_as_float(kr[2] & 0xffff0000u); d[2] = ks * __uint_as_float(kr[3] << 16); d[3] = ks * __uint_as_float(kr[3] & 0xffff0000u);
        *(f32x4*)(qf + t * 132 + cgp * 8) = a; *(f32x4*)(qf + t * 132 + cgp * 8 + 4) = b; *(f32x4*)(kf + t * 132 + cgp * 8) = c2; *(f32x4*)(kf + t * 132 + cgp * 8 + 4) = d; }
#pragma unroll
    for (int it = 0; it < 4; ++it) { const int idx = tid + 512 * it, t = idx >> 5, cgp = idx & 31;
        *(u32x4*)(vb + t * 264 + cgp * 8) = pre.vr[it]; }
    const float mi = pre.mi, mf = pre.mf;
    if (has_next) ml_issue(p, ncgi, nhd, tid, pre);
    if (tid < 64) {
        const float logi = mi + p.b_i[hd]; const float logf = -softplus_f(-(mf + p.b_f[hd]));
        float b = logf;
#pragma unroll
        for (int o = 1; o < 64; o <<= 1) { const float t2 = __shfl_up(b, o); if (lane >= o) b += t2; }
        const float a = logi - b; float px = a;
#pragma unroll
        for (int o = 1; o < 64; o <<= 1) { const float t2 = __shfl_up(px, o); if (lane >= o) px = fmaxf(px, t2); }
        const float p63 = __shfl(px, 63);
        as_[tid] = a; pms[tid] = px; wend[tid] = expf(a - p63);
        ((float*)((unsigned char*)p.out + DO_MB))[(size_t)(row0 + tid) * 8 + hd] = b; ((float*)((unsigned char*)p.out + DO_MDMAX))[(size_t)(row0 + tid) * 8 + hd] = b + px;
    }
    __syncthreads();
    if (wid < 4) {
        const int ti = wid >> 1, tj = wid & 1;
        if (ti == 0 && tj == 1) {
#pragma unroll
            for (int i = 0; i < 16; ++i) pm[crow(i, h) * 68 + 32 + r] = 0.f;
        } else { f32x16 acc;
#pragma unroll
            for (int i = 0; i < 16; ++i) acc[i] = 0.f;
#pragma unroll
            for (int ks = 0; ks < 8; ++ks) acc = MFMA32(ld8f(qf + (ti * 32 + r) * 132 + ks * 16 + h * 8), ld8f(kf + (tj * 32 + r) * 132 + ks * 16 + h * 8), acc);
#pragma unroll
            for (int i = 0; i < 16; ++i) { const int t = ti * 32 + crow(i, h), s = tj * 32 + r; pm[t * 68 + s] = (s <= t) ? acc[i] * __expf(as_[s] - pms[t]) : 0.f; }
        }
    } else if (tid < 256 + 128) { const int k = tid - 256; float a = 0.f;
        for (int s = 0; s < 64; ++s) a += wend[s] * kf[s * 132 + k];
        ((float*)((unsigned char*)p.out + DO_KN))[((size_t)cgi * 8 + hd) * 128 + k] = a; }
    emit_frags(tid, blob, 2, 8, [&](int row, int col) { return qf[row * 132 + col]; });
    emit_frags(tid, blob + 24576, 4, 4, [&](int row, int col) { return kf[col * 132 + row] * wend[col]; });
    for (int idx = tid; idx < 8 * 4 * 64; idx += 512) { const int f = idx >> 6, l = idx & 63, nt = f >> 2, ks = f & 3, c = l & 31, hh = l >> 5;
        const int sb = (ks >> 1) * 32 + (ks & 1) * 16 + 4 * hh; bf16x8 o;
#pragma unroll
        for (int j = 0; j < 8; ++j) o[j] = (short)vb[(sb + 8 * (j >> 2) + (j & 3)) * 264 + nt * 32 + c];
        *(bf16x8*)(blob + 40960 + (size_t)idx * 16) = o; }
    __syncthreads();
    if (tid < 64) { float a = 0.f; for (int s = 0; s < 64; ++s) a += pm[tid * 68 + s]; ((float*)((unsigned char*)p.out + DO_MRS))[(size_t)(row0 + tid) * 8 + hd] = a; }
    emit_frags(tid, blob + 16384, 2, 4, [&](int row, int col) { return pm[row * 68 + col]; });
    __syncthreads();
}

DI void lds_copy_kb(LAS unsigned char* lbuf, const unsigned char* g, int nkb, int wid, int lane) {
    for (int kb = wid; kb < nkb; kb += 8)
        __builtin_amdgcn_global_load_lds((const unsigned*)(g + (size_t)kb * 1024 + lane * 16), (LAS unsigned*)(lbuf + kb * 1024), 16, 0, 0);
}
#define WAIT_ALL_VM() asm volatile("s_waitcnt vmcnt(0)" ::: "memory")
template <int NP> DI void ldp_gdn(u32x4 (&R)[NP], const unsigned char* g, int lw, int lane) {
    const unsigned lo = (unsigned)lane * 16u;
#pragma unroll
    for (int j = 0; j < NP; ++j) { const unsigned char* gj = g + (size_t)((lw * NP + j) * 1024); R[j] = *(const u32x4*)(gj + lo); } }
template <int NP> DI void ldp_ml(u32x4 (&R)[NP], const unsigned char* g, int half, int lw, int lane) {
    const unsigned lo = (unsigned)lane * 16u;
#pragma unroll
    for (int j = 0; j < NP; ++j) { const int kb = lw * NP + j; const unsigned char* gj = g + (size_t)((kb < 40 ? 0 : half * 16384) + kb * 1024); R[j] = *(const u32x4*)(gj + lo); } }
template <int NP> DI void stp(const u32x4 (&R)[NP], LAS unsigned char* l, int lw, int lane) {
#pragma unroll
    for (int j = 0; j < NP; ++j) *(LAS u32x4*)(l + ((lw * NP + j) * 64 + lane) * 16) = R[j]; }

DI void scan_gdn(const Params& p, unsigned char* smem, int seq, int hd) {
    int tid_ = threadIdx.x; asm volatile("" : "+v"(tid_));
    const int tid = tid_, lane = tid & 63, wid = __builtin_amdgcn_readfirstlane(tid >> 6), r = lane & 31, h = lane >> 5, w = wid;
    const int nch = seq < 2 ? 128 : 1, cg0 = seq < 2 ? seq * 128 : 256 + (seq - 2);
    LAS unsigned char* lds = (LAS unsigned char*)smem;
    const unsigned char* blob0 = p.ws + OFF_PREPG + (size_t)gidx(cg0, hd) * BLOB;
    const float* egl = (const float*)((unsigned char*)p.out + DO_EGL);
    const int sbase = (4 * h * 128 + 32 * (w & 3) + r) * 4;
    __syncthreads();
    if (seq >= 2) { lds_copy_kb(lds + BLOB, (const unsigned char*)(p.sg + ((size_t)(seq - 2) * 16 + hd) * 16384), 64, wid, lane); WAIT_ALL_VM(); }
    __syncthreads();
    if (w < 4) {
        f32x16 S[4];
        if (seq >= 2) {
#pragma unroll
            for (int kt = 0; kt < 4; ++kt)
#pragma unroll
                for (int i = 0; i < 16; ++i) S[kt][i] = *(const LAS float*)(lds + BLOB + sbase + (32 * kt + (i & 3) + 8 * (i >> 2)) * 512);
        } else {
#pragma unroll
            for (int kt = 0; kt < 4; ++kt)
#pragma unroll
                for (int i = 0; i < 16; ++i) S[kt][i] = 0.f;
        }
        float eg_next = egl[cg0 * 16 + hd];
        __syncthreads();
        __syncthreads();
        for (int c = 0; c < nch; ++c) {
            const int cur = c & 1; const float eg = eg_next;
            if (c + 1 < nch) eg_next = egl[(cg0 + c + 1) * 16 + hd];
            const LAS unsigned char* buf = lds + cur * BLOB;
            f32x16 U[2], O[2];
#pragma unroll
            for (int mt = 0; mt < 2; ++mt) {
                const LAS bf16x8* up = (const LAS bf16x8*)(buf + 57344 + ((mt * 4 + w) * 64 + lane) * 32);
                const bf16x8 u0 = up[0], u1 = up[1];
#pragma unroll
                for (int i = 0; i < 8; ++i) { U[mt][i] = bf2f((bf16_t)u0[i]); U[mt][8 + i] = bf2f((bf16_t)u1[i]); O[mt][i] = 0.f; O[mt][8 + i] = 0.f; }
            }
#define FRG(off) (*(const LAS bf16x8*)(buf + (off) + lane * 16))
            bf16x8 fcur[6], fnxt[6];
            fcur[0] = FRG(0); fcur[1] = FRG(16384); fcur[2] = FRG(8192); fcur[3] = FRG(24576);
#pragma unroll
            for (int ks = 0; ks < 8; ++ks) {
                if (ks < 7) { fnxt[0] = FRG((ks + 1) * 1024); fnxt[1] = FRG(16384 + (ks + 1) * 1024); fnxt[2] = FRG(8192 + (ks + 1) * 1024); fnxt[3] = FRG(24576 + (ks + 1) * 1024); }
                else { fnxt[0] = FRG(32768); fnxt[1] = FRG(32768 + 4096); fnxt[2] = FRG(40960); fnxt[3] = FRG(40960 + 4096); fnxt[4] = FRG(40960 + 8192); fnxt[5] = FRG(40960 + 12288); }
                const bf16x8 sf = pack_step(S[ks >> 1], ks & 1);
                U[0] = MFMA32(fcur[0], sf, U[0]); O[0] = MFMA32(fcur[1], sf, O[0]); U[1] = MFMA32(fcur[2], sf, U[1]); O[1] = MFMA32(fcur[3], sf, O[1]);
                __builtin_amdgcn_sched_barrier(0);
#pragma unroll
                for (int i = 0; i < 6; ++i) fcur[i] = fnxt[i];
            }
#pragma unroll
            for (int kt = 0; kt < 4; ++kt)
#pragma unroll
                for (int i = 0; i < 16; ++i) S[kt][i] *= eg;
#pragma unroll
            for (int ks = 0; ks < 4; ++ks) {
                if (ks < 3) { fnxt[0] = FRG(32768 + (ks + 1) * 1024); fnxt[1] = FRG(32768 + 4096 + (ks + 1) * 1024);
#pragma unroll
                    for (int kt = 0; kt < 4; ++kt) fnxt[2 + kt] = FRG(40960 + kt * 4096 + (ks + 1) * 1024); }
                const bf16x8 uf = pack_step(U[ks >> 1], ks & 1);
                O[0] = MFMA32(fcur[0], uf, O[0]); O[1] = MFMA32(fcur[1], uf, O[1]);
#pragma unroll
                for (int kt = 0; kt < 4; ++kt) S[kt] = MFMA32(fcur[2 + kt], uf, S[kt]);
                __builtin_amdgcn_sched_barrier(0);
#pragma unroll
                for (int i = 0; i < 6; ++i) fcur[i] = fnxt[i];
            }
#undef FRG
            unsigned long long ob = (unsigned long long)(oraw_blk(p, gidx(cg0 + c, hd)) + (4 * h) * 128 + 32 * w + r);
            asm volatile("" : "+v"(ob));
#pragma unroll
            for (int mt = 0; mt < 2; ++mt)
#pragma unroll
                for (int i = 0; i < 16; ++i) *(GAS bf16_t*)(ob + (size_t)(32 * mt + (i & 3) + 8 * (i >> 2)) * 256) = f2bf(O[mt][i]);
            __syncthreads();
        }
#pragma unroll
        for (int kt = 0; kt < 4; ++kt)
#pragma unroll
            for (int i = 0; i < 16; ++i) *(LAS float*)(lds + sbase + (32 * kt + (i & 3) + 8 * (i >> 2)) * 512) = S[kt][i];
    } else {
        const int lw = w - 4;
        if (nch == 1) {
            u32x4 Ra[18];
            ldp_gdn(Ra, blob0, lw, lane);
            __syncthreads();
            stp(Ra, lds, lw, lane);
            __syncthreads();
            __syncthreads();
        } else {
        u32x4 Ra[18], Rb[18];
        const int last = nch - 1;
#define GBLOB(cc) (blob0 + (size_t)((cc) < last ? (cc) : last) * BLOB)
        ldp_gdn(Ra, blob0, lw, lane);
        __syncthreads();
        stp(Ra, lds, lw, lane);
        ldp_gdn(Rb, GBLOB(1), lw, lane);
        ldp_gdn(Ra, GBLOB(2), lw, lane);
        __syncthreads();
        for (int c = 0; c < nch; c += 2) {
            stp(Rb, lds + BLOB, lw, lane);
            ldp_gdn(Rb, GBLOB(c + 3), lw, lane);
            __syncthreads();
            if (c + 1 < nch) {
                stp(Ra, lds, lw, lane);
                ldp_gdn(Ra, GBLOB(c + 4), lw, lane);
                __syncthreads();
            }
        }
#undef GBLOB
            }
    }
    {   float* dst = p.out + (seq < 2 ? O_GDN_P + ((size_t)seq * 16 + hd) * 16384 : O_GDN_S + ((size_t)(seq - 2) * 16 + hd) * 16384);
        __syncthreads();
        for (int i = tid; i < 4096; i += 512) *(f32x4*)(dst + i * 4) = *(const LAS f32x4*)(lds + i * 16);
        __syncthreads();
    }
}

DI void scan_ml(const Params& p, unsigned char* smem, int seq, int hd, int half) {
    int tid_ = threadIdx.x; asm volatile("" : "+v"(tid_));
    const int tid = tid_, lane = tid & 63, wid = __builtin_amdgcn_readfirstlane(tid >> 6), r = lane & 31, h = lane >> 5, w = wid;
    const int nch = seq < 2 ? 128 : 1, cg0 = seq < 2 ? seq * 128 : 256 + (seq - 2);
    LAS unsigned char* lds = (LAS unsigned char*)smem; float* scr = (float*)(smem + 147456) + wid * 128;
    const unsigned char* blob0 = (const unsigned char*)p.out + DO_PREPM + (size_t)midx(cg0, hd) * BLOB;
    bf16_t* num = (bf16_t*)((unsigned char*)p.out + DO_NUM);
    const float* mbp = (const float*)((unsigned char*)p.out + DO_MB); const float* mdp = (const float*)((unsigned char*)p.out + DO_MDMAX); const float* knp = (const float*)((unsigned char*)p.out + DO_KN);
    float* ncs = (float*)((unsigned char*)p.out + DO_NCS); float* mcs = (float*)((unsigned char*)p.out + DO_MCS);
    const bool nwave = (w == 4) && (half == 0);
    float m = 0.f;
    if (seq >= 2) m = p.sm[(seq - 2) * 8 + hd];
    const int sbase = (4 * h * 128 + 32 * (w & 3) + r) * 4;
    __syncthreads();
    if (seq >= 2) {
        const unsigned char* C0 = (const unsigned char*)(p.sc + ((size_t)(seq - 2) * 8 + hd) * 32768) + half * 512;
        for (int kb = wid; kb < 64; kb += 8)
            __builtin_amdgcn_global_load_lds((const unsigned*)(C0 + (size_t)(2 * kb + (lane >> 5)) * 1024 + (lane & 31) * 16), (LAS unsigned*)(lds + BLOB + kb * 1024), 16, 0, 0);
        WAIT_ALL_VM();
    }
    __syncthreads();
    float bt_n = mbp[((size_t)cg0 * 64 + lane) * 8 + hd], dm_n = mdp[((size_t)cg0 * 64 + lane) * 8 + hd];
    if (w < 4) {
        f32x16 C[4];
        if (seq >= 2) {
#pragma unroll
            for (int kt = 0; kt < 4; ++kt)
#pragma unroll
                for (int i = 0; i < 16; ++i) C[kt][i] = *(const LAS float*)(lds + BLOB + sbase + (32 * kt + (i & 3) + 8 * (i >> 2)) * 512);
        } else {
#pragma unroll
            for (int kt = 0; kt < 4; ++kt)
#pragma unroll
                for (int i = 0; i < 16; ++i) C[kt][i] = 0.f;
        }
        __syncthreads();
        __syncthreads();
        for (int c = 0; c < nch; ++c) {
            const int cur = c & 1; const int cgi = cg0 + c;
            const float bt = bt_n, dm = dm_n;
            if (c + 1 < nch) { bt_n = mbp[((size_t)(cgi + 1) * 64 + lane) * 8 + hd]; dm_n = mdp[((size_t)(cgi + 1) * 64 + lane) * 8 + hd]; }
            const float bL = __shfl(bt, 63), E = __shfl(dm, 63);
            const float inter = bt + m, mtv = fmaxf(inter, dm), wq = __expf(inter - mtv), rr = __expf(dm - mtv);
            const float m_new = __shfl(mtv, 63), wC = __expf(bL + m - m_new), sE = __expf(E - m_new);
            const LAS unsigned char* buf = lds + cur * BLOB;
            scr[lane] = wq; scr[64 + lane] = rr;
#define FRG(off) (*(const LAS bf16x8*)(buf + (off) + lane * 16))
            bf16x8 Vf[4];
#pragma unroll
            for (int ks = 0; ks < 4; ++ks) Vf[ks] = FRG(40960 + (w * 4 + ks) * 1024);
            unsigned long long ob = (unsigned long long)(num + (size_t)midx(cgi, hd) * 16384 + (4 * h) * 256 + half * 128 + 32 * w + r);
            asm volatile("" : "+v"(ob));
            const float* scrh = scr + 4 * h;
            f32x16 QC[2], PV[2];
#pragma unroll
            for (int i = 0; i < 16; ++i) { QC[0][i] = 0.f; QC[1][i] = 0.f; PV[0][i] = 0.f; PV[1][i] = 0.f; }
            bf16x8 fcur[4], fnxt[4];
            fcur[0] = FRG(0); fcur[1] = FRG(8192); fcur[2] = FRG(16384); fcur[3] = FRG(16384 + 4096);
#pragma unroll
            for (int ks = 0; ks < 8; ++ks) {
                if (ks < 7) { fnxt[0] = FRG((ks + 1) * 1024); fnxt[1] = FRG(8192 + (ks + 1) * 1024); if (ks < 3) { fnxt[2] = FRG(16384 + (ks + 1) * 1024); fnxt[3] = FRG(16384 + 4096 + (ks + 1) * 1024); } }
                else { fnxt[0] = FRG(24576); fnxt[1] = FRG(24576 + 4096); fnxt[2] = FRG(24576 + 8192); fnxt[3] = FRG(24576 + 12288); }
                const bf16x8 cf = pack_step(C[ks >> 1], ks & 1);
                QC[0] = MFMA32(fcur[0], cf, QC[0]); QC[1] = MFMA32(fcur[1], cf, QC[1]);
                if (ks < 4) { PV[0] = MFMA32(fcur[2], Vf[ks], PV[0]); PV[1] = MFMA32(fcur[3], Vf[ks], PV[1]); }
                __builtin_amdgcn_sched_barrier(0);
#pragma unroll
                for (int i = 0; i < 4; ++i) fcur[i] = fnxt[i];
            }
#pragma unroll
            for (int kt = 0; kt < 4; ++kt)
#pragma unroll
                for (int i = 0; i < 16; ++i) C[kt][i] *= wC;
#pragma unroll
            for (int ks = 0; ks < 4; ++ks) { float f[8];
#pragma unroll
                for (int j = 0; j < 8; ++j) f[j] = sE * bf2f((bf16_t)Vf[ks][j]);
                Vf[ks] = pack8(f[0], f[1], f[2], f[3], f[4], f[5], f[6], f[7]); }
#pragma unroll
            for (int ks = 0; ks < 4; ++ks) {
                if (ks < 3) {
#pragma unroll
                    for (int kt = 0; kt < 4; ++kt) fnxt[kt] = FRG(24576 + kt * 4096 + (ks + 1) * 1024); }
#pragma unroll
                for (int kt = 0; kt < 4; ++kt) C[kt] = MFMA32(fcur[kt], Vf[ks], C[kt]);
                __builtin_amdgcn_sched_barrier(0);
#pragma unroll
                for (int i = 0; i < 4; ++i) fcur[i] = fnxt[i];
            }
#undef FRG
#pragma unroll
            for (int mt = 0; mt < 2; ++mt)
#pragma unroll
                for (int i = 0; i < 16; ++i) { const int t0 = 32 * mt + (i & 3) + 8 * (i >> 2);
                    *(GAS bf16_t*)(ob + (size_t)t0 * 512) = f2bf(scrh[t0] * QC[mt][i] + scrh[64 + t0] * PV[mt][i]); }
            m = m_new;
            __syncthreads();
        }
#pragma unroll
        for (int kt = 0; kt < 4; ++kt)
#pragma unroll
            for (int i = 0; i < 16; ++i) *(LAS float*)(lds + sbase + (32 * kt + (i & 3) + 8 * (i >> 2)) * 512) = C[kt][i];
    } else {
        const int lw = w - 4;
        float n0 = 0.f, n1 = 0.f, k0_n = 0.f, k1_n = 0.f;
        if (nwave) { if (seq >= 2) { n0 = p.sn[((size_t)(seq - 2) * 8 + hd) * 128 + lane]; n1 = p.sn[((size_t)(seq - 2) * 8 + hd) * 128 + 64 + lane]; }
            k0_n = knp[((size_t)cg0 * 8 + hd) * 128 + lane]; k1_n = knp[((size_t)cg0 * 8 + hd) * 128 + 64 + lane]; }
        auto nstep = [&](int c) {
            const int cgi = cg0 + c;
            const float bt = bt_n, dm = dm_n, k0 = k0_n, k1 = k1_n;
            if (c + 1 < nch) { bt_n = mbp[((size_t)(cgi + 1) * 64 + lane) * 8 + hd]; dm_n = mdp[((size_t)(cgi + 1) * 64 + lane) * 8 + hd];
                k0_n = knp[((size_t)(cgi + 1) * 8 + hd) * 128 + lane]; k1_n = knp[((size_t)(cgi + 1) * 8 + hd) * 128 + 64 + lane]; }
            const float bL = __shfl(bt, 63), E = __shfl(dm, 63);
            const float mtv = fmaxf(bt + m, dm);
            const float m_new = __shfl(mtv, 63), wC = __expf(bL + m - m_new), sE = __expf(E - m_new);
            ncs[((size_t)cgi * 8 + hd) * 128 + lane] = n0; ncs[((size_t)cgi * 8 + hd) * 128 + 64 + lane] = n1;
            if (lane == 0) mcs[cgi * 8 + hd] = m;
            n0 = wC * n0 + sE * k0; n1 = wC * n1 + sE * k1;
            m = m_new;
        };
        if (nch == 1) {
            u32x4 Ra[14];
            ldp_ml(Ra, blob0, half, lw, lane);
            __syncthreads();
            stp(Ra, lds, lw, lane);
            __syncthreads();
            if (nwave) nstep(0);
            __syncthreads();
        } else {
        u32x4 Ra[14], Rb[14];
        const int last = nch - 1;
#define MBLOB(cc) (blob0 + (size_t)((cc) < last ? (cc) : last) * BLOB)
        ldp_ml(Ra, blob0, half, lw, lane);
        __syncthreads();
        stp(Ra, lds, lw, lane);
        ldp_ml(Rb, MBLOB(1), half, lw, lane);
        ldp_ml(Ra, MBLOB(2), half, lw, lane);
        __syncthreads();
        for (int c = 0; c < nch; c += 2) {
            stp(Rb, lds + BLOB, lw, lane);
            ldp_ml(Rb, MBLOB(c + 3), half, lw, lane);
            if (nwave) nstep(c);
            __syncthreads();
            if (c + 1 < nch) {
                stp(Ra, lds, lw, lane);
                ldp_ml(Ra, MBLOB(c + 4), half, lw, lane);
                if (nwave) nstep(c + 1);
                __syncthreads();
            }
        }
        }
#undef MBLOB
        if (nwave) {
            float* dn = p.out + (seq < 2 ? O_N_P + ((size_t)seq * 8 + hd) * 128 : O_N_S + ((size_t)(seq - 2) * 8 + hd) * 128);
            dn[lane] = n0; dn[64 + lane] = n1;
            if (lane == 0) p.out[(seq < 2 ? O_M_P + seq * 8 + hd : O_M_S + (seq - 2) * 8 + hd)] = m;
        }
    }
    {   float* dst = p.out + (seq < 2 ? O_C_P + ((size_t)seq * 8 + hd) * 32768 : O_C_S + ((size_t)(seq - 2) * 8 + hd) * 32768) + half * 128;
        __syncthreads();
        for (int i = tid; i < 4096; i += 512) *(f32x4*)(dst + (i >> 5) * 256 + (i & 31) * 4) = *(const LAS f32x4*)(lds + i * 16);
        __syncthreads();
    }
}

struct TableOrder {
    const unsigned* tab; int n, G, c; bool remap;
    DI bool next(int i, pg8::Unit& u) const {
        const long L = (long)i * G + c; if (L >= n) return false;
        int w = (int)L;
        if (remap) { const int q = n / 8, r = n % 8, xcd = w % 8, off = w / 8; w = (xcd < r ? xcd * (q + 1) : r * (q + 1) + (xcd - r) * q) + off; }
        const unsigned v = tab[w]; u.pm = (int)(v >> 8); u.pn = (int)(v & 255u); return true;
    }
    DI void a_ready(const pg8::Unit&) const {}
    DI void done(const pg8::Unit&) const {}
};
DI void gemm1_units(const Params& p, unsigned char* smem, const unsigned* tab, int n, int G, int c, bool remap) {
    pg8::Gemm g; g.A = (const bf16_t*)(p.ws + OFF_H); g.Bt = (const bf16_t*)(p.ws + OFF_BT1); g.M = NTOK; g.N = N1; g.K = DM;
    TableOrder S; S.tab = tab; S.n = n; S.G = G; S.c = c; S.remap = remap;
    Epi1 E; E.pa = (bf16_t*)(p.ws + OFF_PA); E.pb = (bf16_t*)(p.ws + OFF_PB); E.gates = (float*)((unsigned char*)p.out + DO_GATES);
    pg8::gemm_phase<Epi1, TableOrder, false>((LAS unsigned char*)smem, g, S, E, nullptr);
    __syncthreads();
}
DI void phase1(const Params& p, unsigned char* smem) {
    gemm1_units(p, smem, (const unsigned*)((const unsigned char*)p.out + DO_TABK), NKEPT, (int)gridDim.x, (int)blockIdx.x, true);
}
DI void phase3(const Params& p, unsigned char* smem) {
    const int b = blockIdx.x;
    if (b < 32) { if (p.mode3 & 1) scan_gdn(p, smem, b >> 4, b & 15); }
    else if (b < 64) { if (p.mode3 & 1) { const int i = b - 32; scan_ml(p, smem, i >> 4, (i >> 1) & 7, i & 1); } }
    else {
        if (p.mode3 & 2) {
            const int c = b - 64; int it0 = c, step = (int)gridDim.x - 64, itend = 1024;
            if (gridDim.x == 256) {
                if (c < 144) { step = 144; itend = 576; } else { it0 = 576 + (c - 144); step = 48; } }
#pragma unroll 1
            for (int it = it0; it < itend; it += step) {
                if (it < 512) scan_gdn(p, smem, 2 + (it >> 4), it & 15);
                else { const int i = it - 512; scan_ml(p, smem, 2 + (i >> 4), (i >> 1) & 7, i & 1); }
                __syncthreads();
            }
        }
        __syncthreads();
        if (p.mode3 & 4) gemm1_units(p, smem, (const unsigned*)((const unsigned char*)p.out + DO_TABD), NDEF, (int)gridDim.x - 64, b - 64, false);
    }
}

DI void unpk8(const u32x4 v, float (&f)[8]) {
#pragma unroll
    for (int i = 0; i < 4; ++i) { f[2 * i] = __uint_as_float(v[i] << 16); f[2 * i + 1] = __uint_as_float(v[i] & 0xffff0000u); } }
DI void phase4(const Params& p, unsigned char* smem) {
    int tid_ = threadIdx.x; asm volatile("" : "+v"(tid_));
    const int tid = tid_, lane = tid & 63, wid = tid >> 6;
    const int gw = blockIdx.x * 8 + wid, nw = gridDim.x * 8;
    const bf16_t* num = (const bf16_t*)((const unsigned char*)p.out + DO_NUM);
    const bf16_t* pa = (const bf16_t*)(p.ws + OFF_PA); const bf16_t* pb = (const bf16_t*)(p.ws + OFF_PB);
    const float* mbp = (const float*)((unsigned char*)p.out + DO_MB); const float* mdp = (const float*)((unsigned char*)p.out + DO_MDMAX); const float* mrs = (const float*)((unsigned char*)p.out + DO_MRS);
    const float* ncs = (const float*)((unsigned char*)p.out + DO_NCS); const float* mcs = (const float*)((unsigned char*)p.out + DO_MCS);
    bf16_t* mixed = (bf16_t*)(p.ws + OFF_MIXED);
    const int hm = lane >> 3, sub = lane & 7;
    transpose_tiles(p, smem, tid, true);
    for (int row = gw; row < NTOK; row += nw) {
        const int cgi = row >> 6;
        const bf16_t* orow = oraw_blk(p, gidx(cgi, lane >> 2)) + (row & 63) * 128 + (lane & 3) * 32;
        u32x4 ov[4], zv[4];
#pragma unroll
        for (int i = 0; i < 4; ++i) { ov[i] = *(const u32x4*)(orow + i * 8); zv[i] = *(const u32x4*)(pb + (size_t)row * NB + lane * 32 + i * 8); }
        {
            float ss = 0.f;
#pragma unroll
            for (int i = 0; i < 4; ++i) { float f[8]; unpk8(ov[i], f);
#pragma unroll
                for (int j = 0; j < 8; ++j) ss += f[j] * f[j]; }
            ss += __shfl_xor(ss, 1); ss += __shfl_xor(ss, 2);
            const float rs = rsqrtf(ss * (1.f / 128.f) + 1e-6f);
#pragma unroll
            for (int i = 0; i < 4; ++i) { float f[8], z[8]; unpk8(ov[i], f); unpk8(zv[i], z);
                const f32x4 g0 = *(const f32x4*)(p.gdn_nw + (lane & 3) * 32 + i * 8), g1 = *(const f32x4*)(p.gdn_nw + (lane & 3) * 32 + i * 8 + 4);
                u32x4 o; o[0] = pk2(f[0] * rs * g0[0] * silu_f(z[0]), f[1] * rs * g0[1] * silu_f(z[1])); o[1] = pk2(f[2] * rs * g0[2] * silu_f(z[2]), f[3] * rs * g0[3] * silu_f(z[3]));
                o[2] = pk2(f[4] * rs * g1[0] * silu_f(z[4]), f[5] * rs * g1[1] * silu_f(z[5])); o[3] = pk2(f[6] * rs * g1[2] * silu_f(z[6]), f[7] * rs * g1[3] * silu_f(z[7]));
                *(u32x4*)(mixed + (size_t)row * DM + lane * 32 + i * 8) = o; }
        }
        __builtin_amdgcn_sched_barrier(0);
        u32x4 nv[4], mov[4], mzv[4], qv[2]; f32x4 nn[4];
#pragma unroll
        for (int i = 0; i < 4; ++i) { nv[i] = *(const u32x4*)(num + (size_t)midx(cgi, hm) * 16384 + (row & 63) * 256 + sub * 32 + i * 8); mov[i] = *(const u32x4*)(pb + (size_t)row * NB + 2048 + lane * 32 + i * 8);
            mzv[i] = *(const u32x4*)(pb + (size_t)row * NB + 4096 + lane * 32 + i * 8); nn[i] = *(const f32x4*)(ncs + ((size_t)cgi * 8 + hm) * 128 + sub * 16 + i * 4); }
        qv[0] = *(const u32x4*)(pa + (size_t)row * NA + 6144 + hm * 128 + sub * 16); qv[1] = *(const u32x4*)(pa + (size_t)row * NA + 6144 + hm * 128 + sub * 16 + 8);
        const float mc = mcs[cgi * 8 + hm], bt = mbp[(size_t)row * 8 + hm], dm = mdp[(size_t)row * 8 + hm], rsm = mrs[(size_t)row * 8 + hm];
        {
            float qf8[8], qn = 0.f;
            unpk8(qv[0], qf8); qn += qf8[0] * nn[0][0] + qf8[1] * nn[0][1] + qf8[2] * nn[0][2] + qf8[3] * nn[0][3] + qf8[4] * nn[1][0] + qf8[5] * nn[1][1] + qf8[6] * nn[1][2] + qf8[7] * nn[1][3];
            unpk8(qv[1], qf8); qn += qf8[0] * nn[2][0] + qf8[1] * nn[2][1] + qf8[2] * nn[2][2] + qf8[3] * nn[2][3] + qf8[4] * nn[3][0] + qf8[5] * nn[3][1] + qf8[6] * nn[3][2] + qf8[7] * nn[3][3];
            qn += __shfl_xor(qn, 1); qn += __shfl_xor(qn, 2); qn += __shfl_xor(qn, 4);
            const float inter = bt + mc, mtv = fmaxf(inter, dm), wq = __expf(inter - mtv), rr = __expf(dm - mtv);
            const float den = wq * qn + rr * rsm; const float inv = 1.f / fmaxf(fabsf(den), __expf(-mtv));
            float ss = 0.f;
#pragma unroll
            for (int i = 0; i < 4; ++i) { float f[8]; unpk8(nv[i], f);
#pragma unroll
                for (int j = 0; j < 8; ++j) { const float hv = f[j] * inv; ss += hv * hv; } }
            ss += __shfl_xor(ss, 1); ss += __shfl_xor(ss, 2); ss += __shfl_xor(ss, 4);
            const float rs = rsqrtf(ss * (1.f / 256.f) + 1e-6f) * inv;
#pragma unroll
            for (int i = 0; i < 4; ++i) { float f[8], a[8], z[8]; unpk8(nv[i], f); unpk8(mov[i], a); unpk8(mzv[i], z);
                const f32x4 g0 = *(const f32x4*)(p.ml_nw + sub * 32 + i * 8), g1 = *(const f32x4*)(p.ml_nw + sub * 32 + i * 8 + 4);
                u32x4 o; o[0] = pk2(f[0] * rs * g0[0] * sigm_f(a[0]) * silu_f(z[0]), f[1] * rs * g0[1] * sigm_f(a[1]) * silu_f(z[1]));
                o[1] = pk2(f[2] * rs * g0[2] * sigm_f(a[2]) * silu_f(z[2]), f[3] * rs * g0[3] * sigm_f(a[3]) * silu_f(z[3]));
                o[2] = pk2(f[4] * rs * g1[0] * sigm_f(a[4]) * silu_f(z[4]), f[5] * rs * g1[1] * sigm_f(a[5]) * silu_f(z[5]));
                o[3] = pk2(f[6] * rs * g1[2] * sigm_f(a[6]) * silu_f(z[6]), f[7] * rs * g1[3] * sigm_f(a[7]) * silu_f(z[7]));
                *(u32x4*)(mixed + (size_t)row * DM + 2048 + lane * 32 + i * 8) = o; }
        }
    }
    for (int i = blockIdx.x * 512 + tid; i < 34 * 3 * 6144; i += gridDim.x * 512) {
        const int c = i % 6144, j = (i / 6144) % 3, s = i / (3 * 6144);
        const size_t row = s < 2 ? (size_t)s * 8192 + 8189 + j : (size_t)NPR + (size_t)(s - 2) * 64 + 61 + j;
        const float v = bf2f(pa[row * NA + c]);
        if (s < 2) p.out[O_CONV_P + ((size_t)s * 3 + j) * 6144 + c] = v; else p.out[O_CONV_S + ((size_t)(s - 2) * 3 + j) * 6144 + c] = v;
    }
}

DI void phase6(const Params& p) {
    int tid_ = threadIdx.x; asm volatile("" : "+v"(tid_));
    const int tid = tid_, lane = tid & 63, wid = tid >> 6;
    const int gw = blockIdx.x * 8 + wid, nw = gridDim.x * 8;
    const float* rowss = (const float*)(p.ws + OFF_ROWSS);
    for (int row = gw; row < NTOK; row += nw) {
        float* yr = p.out + (size_t)row * DM; const float rs = rsqrtf(rowss[row] * (1.f / DM) + 1e-6f);
#pragma unroll
        for (int i = 0; i < 16; ++i) { const f32x4 g = *(const f32x4*)(p.final_g + (lane + 64 * i) * 4); f32x4 v = *(const f32x4*)(yr + (lane + 64 * i) * 4);
            v[0] *= rs * g[0]; v[1] *= rs * g[1]; v[2] *= rs * g[2]; v[3] *= rs * g[3]; *(f32x4*)(yr + (lane + 64 * i) * 4) = v; }
    }
}

DI void phase2(const Params& p, unsigned char* smem) {
    const int G = gridDim.x; int it = blockIdx.x;
    {   PreG pre;
        if (it < 4608) gdn_issue(p, it >> 4, it & 15, threadIdx.x, pre);
#pragma unroll 1
        for (; it < 4608; it += G) { const int nit = it + G; prep_gdn(p, smem, it >> 4, it & 15, pre, nit >> 4, nit & 15, nit < 4608); }
    }
    {   PreM pre;
        if (it < 6912) ml_issue(p, (it - 4608) >> 3, (it - 4608) & 7, threadIdx.x, pre);
#pragma unroll 1
        for (; it < 6912; it += G) { const int nit = it + G; prep_ml(p, smem, (it - 4608) >> 3, (it - 4608) & 7, pre, (nit - 4608) >> 3, (nit - 4608) & 7, nit < 6912); }
    }
}
DI void phase5(const Params& p, unsigned char* smem) {
    pg8::Gemm g; g.A = (const bf16_t*)(p.ws + OFF_MIXED); g.Bt = (const bf16_t*)(p.ws + OFF_BT2); g.M = NTOK; g.N = DM; g.K = DM;
    pg8::StaticOrder S; S.init(g.M, g.N, (int)gridDim.x, (int)blockIdx.x);
    Epi2 E; E.xp = p.xp; E.xs = p.xs; E.y = p.out; E.rowss = (float*)(p.ws + OFF_ROWSS);
    pg8::gemm_phase<Epi2, pg8::StaticOrder, false>((LAS unsigned char*)smem, g, S, E, nullptr);
    __syncthreads();
}

__global__ __launch_bounds__(512, 2) void mega(Params p) {
    extern __shared__ __attribute__((aligned(16))) unsigned char smem[];
    cg::grid_group grid = cg::this_grid();
#ifndef PHMASK
#define PHMASK 127
#endif
#ifndef DBLMASK
#define DBLMASK 0
#endif
#define PHASE(i, call) if constexpr ((PHMASK >> (i)) & 1) { if (p.ph_lo <= (i) && (i) <= p.ph_hi) { call; if ((i) < p.ph_hi) grid.sync(); } }
    PHASE(0, phase0(p, smem))
    PHASE(1, phase1(p, smem))
    PHASE(2, phase2(p, smem))
    PHASE(3, phase3(p, smem))
    PHASE(4, phase4(p, smem))
    PHASE(5, phase5(p, smem))
    PHASE(6, phase6(p))
}

#ifndef N_LAUNCH_SPLIT
#define N_LAUNCH_SPLIT 1
#endif
extern "C" void kernel_launch(void* const* d_in, const int* in_sizes, int n_in, void* d_out, int out_size, void* d_ws, size_t ws_size, hipStream_t stream) {
    static int grid = 0;
    if (grid == 0) {
        if (ws_size < WS_END || n_in != 18) { fprintf(stderr, "kernel_launch: workspace %zu < %zu or n_in %d != 18\n", ws_size, (size_t)WS_END, n_in); grid = -1; return; }
        int dev = 0, cus = 0, per_cu = 0;
        (void)hipGetDevice(&dev); (void)hipDeviceGetAttribute(&cus, hipDeviceAttributeMultiprocessorCount, dev);
        (void)hipFuncSetAttribute((const void*)mega, hipFuncAttributeMaxDynamicSharedMemorySize, LDS_BYTES);
        (void)hipOccupancyMaxActiveBlocksPerMultiprocessor(&per_cu, (const void*)mega, 512, LDS_BYTES);
        if (per_cu < 1) { fprintf(stderr, "kernel_launch: occupancy query says %d blocks/CU\n", per_cu); per_cu = 1; }
        (void)hipGetLastError();
        grid = cus;
    }
    if (grid < 0) return;
    Params p{};
    p.xp = (const float*)d_in[0]; p.xs = (const float*)d_in[1]; p.cache = (const float*)d_in[2]; p.sg = (const float*)d_in[3]; p.sc = (const float*)d_in[4];
    p.sn = (const float*)d_in[5]; p.sm = (const float*)d_in[6]; p.norm_g = (const float*)d_in[7]; p.w_in = (const float*)d_in[8]; p.conv_w = (const float*)d_in[9];
    p.a_log = (const float*)d_in[10]; p.dt_bias = (const float*)d_in[11]; p.gdn_nw = (const float*)d_in[12]; p.b_i = (const float*)d_in[13]; p.b_f = (const float*)d_in[14];
    p.ml_nw = (const float*)d_in[15]; p.w_out = (const float*)d_in[16]; p.final_g = (const float*)d_in[17];
    p.out = (float*)d_out; p.ws = (unsigned char*)d_ws; p.mode3 = 7;
#if N_LAUNCH_SPLIT == 1
    p.ph_lo = 0; p.ph_hi = 6;
    void* args[] = {&p};
    hipError_t e = hipLaunchCooperativeKernel((const void*)mega, dim3(grid), dim3(512), args, LDS_BYTES, stream);
    if (e != hipSuccess) fprintf(stderr, "cooperative launch failed: %s (grid %d)\n", hipGetErrorString(e), grid);
#else
    for (int ph = 0; ph <= 6; ++ph) { p.ph_lo = ph; p.ph_hi = ph; const int reps = 1 + ((DBLMASK >> ph) & 1);
        for (int rep = 0; rep < reps; ++rep) hipLaunchKernelGGL(mega, dim3(grid), dim3(512), LDS_BYTES, stream, p);
        if (ph == 3 && (DBLMASK >> 7)) { p.mode3 = (DBLMASK >> 7) & 7; hipLaunchKernelGGL(mega, dim3(grid), dim3(512), LDS_BYTES, stream, p); p.mode3 = 7; } }
#endif
}
```
